# Optimizing an MI355X kernel written in HIP

```python
import math
import jax, jax.numpy as jnp
from jax import lax
import numpy as np

D_MODEL = 1024
BATCH = 2
SEQ = 8192
DEPTH = 1

SSM_GROUP = 16
SSM_GROUPS = D_MODEL // 32
SSM_WIDTH = SSM_GROUP * SSM_GROUPS
SSM_STATE = 64
DT_MIN = 1e-3
DT_MAX = 1e-1
FOX_HEAD_DIM = 64
FOX_HEADS = D_MODEL // 128
FOX_WIDTH = FOX_HEADS * FOX_HEAD_DIM
Q_BLOCK = 128
MEM_LEN = 256
MEM_HEADS = 4
MEM_HEAD_DIM = 128
MEM_WIDTH = MEM_HEADS * MEM_HEAD_DIM
FFN_HIDDEN = -(-8 * D_MODEL // (3 * 256)) * 256
N_BRANCHES = 2
RMS_EPS = 1e-6
SPLIT_Q = SSM_WIDTH
SPLIT_K = SPLIT_Q + FOX_WIDTH
SPLIT_V = SPLIT_K + FOX_WIDTH
SPLIT_F = SPLIT_V + FOX_WIDTH
SPLIT_G = SPLIT_F + FOX_HEADS
IN_WIDTH = SPLIT_G + N_BRANCHES * D_MODEL

kernel_name = "hybrid_s5_fox_gated_block"


def rms_norm(x, gain):
    xf = x.astype(jnp.float32)
    y = xf * lax.rsqrt(jnp.mean(xf * xf, axis=-1, keepdims=True) + RMS_EPS)
    return (y * gain.astype(jnp.float32)).astype(x.dtype)


def _linear_recurrence_op(left, right):
    a1, b1 = left
    a2, b2 = right
    return a1 * a2, a2 * b1 + b2


def s5_ssm(u, lam_re, lam_im, log_dt, b_re, b_im, c_re, c_im, d_skip):
    bsz, seq, _ = u.shape
    f32 = jnp.float32
    uf = u.astype(f32).reshape(bsz, seq, SSM_GROUPS, SSM_GROUP)
    lam = lax.complex(lam_re.astype(f32), lam_im.astype(f32))
    dt = jnp.exp(log_dt.astype(f32))[:, None]
    lam_bar = jnp.exp(lam * dt)
    b = lax.complex(b_re.astype(f32), b_im.astype(f32))
    b_bar = ((lam_bar - 1.0) / lam)[..., None] * b
    c = lax.complex(c_re.astype(f32), c_im.astype(f32))
    bu = jnp.einsum('gpn,blgn->blgp', b_bar, uf.astype(jnp.complex64))
    a = jnp.broadcast_to(lam_bar, bu.shape)
    _, states = lax.associative_scan(_linear_recurrence_op, (a, bu), axis=1)
    y = jnp.einsum('gnp,blgp->blgn', c, states).real
    y = y + d_skip.astype(f32).reshape(SSM_GROUPS, SSM_GROUP) * uf
    return y.reshape(bsz, seq, SSM_WIDTH).astype(u.dtype)


def forgetting_attention(q, k, v, f_logit):
    bsz, seq, n_heads, head_dim = q.shape
    log_f = jax.nn.log_sigmoid(f_logit.astype(jnp.float32))
    cum = jnp.cumsum(log_f, axis=1).transpose(0, 2, 1)
    kh = k.transpose(0, 2, 1, 3)
    vh = v.transpose(0, 2, 1, 3)
    n_blocks = seq // Q_BLOCK
    q_blocks = q.transpose(0, 2, 1, 3).reshape(bsz, n_heads, n_blocks, Q_BLOCK, head_dim).transpose(2, 0, 1, 3, 4)
    c_blocks = cum.reshape(bsz, n_heads, n_blocks, Q_BLOCK).transpose(2, 0, 1, 3)
    starts = jnp.arange(n_blocks, dtype=jnp.int32) * Q_BLOCK
    key_pos = jnp.arange(seq, dtype=jnp.int32)
    scale = head_dim ** -0.5

    def one_block(args):
        qb, cb, start = args
        s = jnp.einsum('bhqd,bhkd->bhqk', qb, kh).astype(jnp.float32) * scale
        s = s + cb[..., :, None] - cum[..., None, :]
        q_pos = start + jnp.arange(Q_BLOCK, dtype=jnp.int32)
        causal = key_pos[None, :] <= q_pos[:, None]
        s = jnp.where(causal, s, -jnp.inf)
        p = jax.nn.softmax(s, axis=-1)
        return jnp.einsum('bhqk,bhkd->bhqd', p.astype(vh.dtype), vh)

    out = lax.map(one_block, (q_blocks, c_blocks, starts))
    return out.transpose(1, 0, 3, 2, 4).reshape(bsz, seq, n_heads * head_dim)


def memory_cross_attention(n, m, w_q, w_kv, w_o):
    bsz, seq, _ = n.shape
    mem_len = m.shape[1]
    q = (n @ w_q).reshape(bsz, seq, MEM_HEADS, MEM_HEAD_DIM)
    k, v = jnp.split(m @ w_kv, 2, axis=-1)
    k = k.reshape(bsz, mem_len, MEM_HEADS, MEM_HEAD_DIM)
    v = v.reshape(bsz, mem_len, MEM_HEADS, MEM_HEAD_DIM)
    s = jnp.einsum('blhd,bmhd->bhlm', q, k).astype(jnp.float32) * (MEM_HEAD_DIM ** -0.5)
    p = jax.nn.softmax(s, axis=-1)
    o = jnp.einsum('bhlm,bmhd->blhd', p.astype(v.dtype), v).reshape(bsz, seq, MEM_WIDTH)
    return o @ w_o


def setup_inputs(seed: int = 0) -> dict:
    key = jax.random.key(seed)
    ks = jax.random.split(key, 32)
    f32 = jnp.float32
    L = DEPTH

    def nrm(k, shape, fan_in):
        return jax.random.normal(k, shape, f32) * (fan_in ** -0.5)

    def gain(k, shape):
        return 1.0 + 0.01 * jax.random.normal(k, shape, f32)

    n_idx = jnp.arange(SSM_STATE, dtype=f32)
    lam_re = -0.5 + 0.01 * jax.random.normal(ks[4], (L, SSM_GROUPS, SSM_STATE), f32)
    lam_im = math.pi * n_idx + 0.01 * jax.random.normal(ks[5], (L, SSM_GROUPS, SSM_STATE), f32)
    log_dt = jax.random.uniform(ks[6], (L, SSM_GROUPS), f32, math.log(DT_MIN), math.log(DT_MAX))
    return {
        "x": jax.random.normal(ks[0], (BATCH, SEQ, D_MODEL), f32),
        "mem": jax.random.normal(ks[1], (BATCH, MEM_LEN, D_MODEL), f32),
        "norm_mix": gain(ks[2], (L, D_MODEL)),
        "w_in": nrm(ks[3], (L, D_MODEL, IN_WIDTH), D_MODEL),
        "b_forget": jax.random.uniform(ks[7], (L, FOX_HEADS), f32, 1.0, 5.0),
        "lam_re": lam_re,
        "lam_im": lam_im,
        "log_dt": log_dt,
        "b_re": nrm(ks[8], (L, SSM_GROUPS, SSM_STATE, SSM_GROUP), 2 * SSM_GROUP),
        "b_im": nrm(ks[9], (L, SSM_GROUPS, SSM_STATE, SSM_GROUP), 2 * SSM_GROUP),
        "c_re": nrm(ks[10], (L, SSM_GROUPS, SSM_GROUP, SSM_STATE), SSM_STATE),
        "c_im": nrm(ks[11], (L, SSM_GROUPS, SSM_GROUP, SSM_STATE), SSM_STATE),
        "d_skip": jax.random.normal(ks[12], (L, SSM_WIDTH), f32),
        "w_glu": nrm(ks[13], (L, SSM_WIDTH, 2 * D_MODEL), SSM_WIDTH),
        "w_fox_o": nrm(ks[14], (L, FOX_WIDTH, D_MODEL), FOX_WIDTH),
        "w_mix_out": nrm(ks[15], (L, D_MODEL, D_MODEL), D_MODEL),
        "norm_mem_q": gain(ks[16], (L, D_MODEL)),
        "norm_mem_kv": gain(ks[17], (L, D_MODEL)),
        "w_mem_q": nrm(ks[18], (L, D_MODEL, MEM_WIDTH), D_MODEL),
        "w_mem_kv": nrm(ks[19], (L, D_MODEL, 2 * MEM_WIDTH), D_MODEL),
        "w_mem_o": nrm(ks[20], (L, MEM_WIDTH, D_MODEL), MEM_WIDTH),
        "norm_ffn": gain(ks[21], (L, D_MODEL)),
        "w_ffn_in": nrm(ks[22], (L, D_MODEL, 2 * FFN_HIDDEN), D_MODEL),
        "w_ffn_out": nrm(ks[23], (L, FFN_HIDDEN, D_MODEL), FFN_HIDDEN),
        "norm_final": gain(ks[24], (D_MODEL,)),
    }


def reference(x, mem, norm_mix, w_in, b_forget, lam_re, lam_im, log_dt, b_re, b_im, c_re, c_im,
              d_skip, w_glu, w_fox_o, w_mix_out, norm_mem_q, norm_mem_kv, w_mem_q, w_mem_kv,
              w_mem_o, norm_ffn, w_ffn_in, w_ffn_out, norm_final):
    bsz, seq, _ = x.shape
    h = x
    for l in range(DEPTH):
        u = rms_norm(h, norm_mix[l])
        proj = u @ w_in[l]
        u_ssm, q, k, v, f_logit, gate_logits = jnp.split(
            proj, [SPLIT_Q, SPLIT_K, SPLIT_V, SPLIT_F, SPLIT_G], axis=-1)
        y_ssm = jax.nn.gelu(s5_ssm(u_ssm, lam_re[l], lam_im[l], log_dt[l], b_re[l], b_im[l],
                                   c_re[l], c_im[l], d_skip[l]))
        glu_a, glu_b = jnp.split(y_ssm @ w_glu[l], 2, axis=-1)
        out_a = glu_a * jax.nn.sigmoid(glu_b)
        att = forgetting_attention(
            q.reshape(bsz, seq, FOX_HEADS, FOX_HEAD_DIM),
            k.reshape(bsz, seq, FOX_HEADS, FOX_HEAD_DIM),
            v.reshape(bsz, seq, FOX_HEADS, FOX_HEAD_DIM),
            f_logit + b_forget[l])
        out_b = att @ w_fox_o[l]
        gate_a, gate_b = jnp.split(jax.nn.sigmoid(gate_logits), 2, axis=-1)
        h = h + (gate_a * out_a + gate_b * out_b) @ w_mix_out[l]
        h = h + memory_cross_attention(rms_norm(h, norm_mem_q[l]), rms_norm(mem, norm_mem_kv[l]),
                                       w_mem_q[l], w_mem_kv[l], w_mem_o[l])
        f_a, f_b = jnp.split(rms_norm(h, norm_ffn[l]) @ w_ffn_in[l], 2, axis=-1)
        h = h + (jax.nn.silu(f_a) * f_b) @ w_ffn_out[l]
    return rms_norm(h, norm_final)
```

```cpp
#include <hip/hip_runtime.h>
#include <hip/hip_cooperative_groups.h>
#include <cstdio>
#include <cstdint>
#include <cmath>
namespace cg = cooperative_groups;

#ifndef MK_ONE_LAUNCH
#define MK_ONE_LAUNCH 1
#endif
#undef MK_ONE_LAUNCH
#define MK_ONE_LAUNCH 1
namespace pg8 {
#define PG8_LAS __attribute__((address_space(3)))
typedef unsigned short bf16_t;
typedef short bf16x8 __attribute__((ext_vector_type(8)));
typedef float f32x4 __attribute__((ext_vector_type(4)));
typedef unsigned u32x4 __attribute__((ext_vector_type(4)));
constexpr int BM = 256, BK = 64, HALF = 128, HTB = HALF * BK * 2  , STAGE_BYTES = 8 * HTB, NXCD = 8, WGM = 8;

__host__ __device__ __forceinline__ int lds_byte(int r, int c) { const int st = (r >> 4) * 2 + (c >> 5), rr = r & 15, cc = c & 31, ob = rr * 64 + cc * 2; return st * 1024 + (ob ^ (((ob >> 9) & 1) << 5)); }
__host__ __device__ __forceinline__ void stage_rc(int b, int& R, int& C) { const int st = b / 1024, sb = b % 1024, swz = sb ^ (((sb >> 9) & 1) << 5); R = (st >> 1) * 16 + swz / 64; C = (st & 1) * 32 + (swz % 64) / 2; }
__host__ __device__ __forceinline__ int perm32(int rho) { const int n = rho >> 4, i = rho & 15; return 8 * (i >> 2) + 4 * n + (i & 3); }

struct Unit { int pm, pn; };
struct Gemm { const bf16_t* A; const bf16_t* Bt; int M, N, K; };

struct StaticOrder {
    int nM, nN, nwg, G, c;
    __host__ __device__ void init(int M, int N, int G_, int c_) { nM = M / BM; nN = N / BM; nwg = nM * nN; G = G_; c = c_; }
    __host__ __device__ bool next(int i, Unit& u) const {
        const long L = (long)i * G + c; if (L >= nwg) return false;
        int wgid = (int)L; { const int q = nwg / NXCD, r = nwg % NXCD, xcd = wgid % NXCD, off = wgid / NXCD; wgid = (xcd < r ? xcd * (q + 1) : r * (q + 1) + (xcd - r) * q) + off; }
        const int nig = WGM * nN, gid = wgid / nig, fm = gid * WGM, gsz = (nM - fm) < WGM ? (nM - fm) : WGM;
        u.pm = fm + ((wgid % nig) % gsz); u.pn = (wgid % nig) / gsz; return true;
    }
    __device__ __forceinline__ void a_ready(const Unit&) const {}
    __device__ __forceinline__ void done(const Unit&) const {}
};

__device__ __forceinline__ unsigned cvt_pk_bf16(float lo, float hi) { unsigned r; asm volatile("v_cvt_pk_bf16_f32 %0, %1, %2" : "=v"(r) : "v"(lo), "v"(hi)); return r; }
typedef float f32x2 __attribute__((ext_vector_type(2)));
template <class Epi, class Sched, bool ALIGN_EPI = false, bool SP2 = false>
__device__ __forceinline__ void gemm_phase(PG8_LAS unsigned char* lds, const Gemm g, const Sched& S, const Epi& E) {
    const int tid = threadIdx.x, wid = __builtin_amdgcn_readfirstlane(tid >> 6), lane = tid & 63, wr = wid >> 2, wc = wid & 3, fr = lane & 15, fq = lane >> 4;
    const int K = g.K, nt = K / BK;
    unsigned voffA[2], voffB[2];
#pragma unroll
    for (int i = 0; i < 2; ++i) { int R, C; stage_rc(tid * 16 + i * 8192, R, C); const int Rb = Epi::PERM ? ((R & ~31) + perm32(R & 31)) : R;
        voffA[i] = (unsigned)(R * K + C) * 2u; voffB[i] = (unsigned)(Rb * K + C) * 2u; }
    const size_t kstep = (size_t)(BK * 2);
    const size_t hstep = (size_t)HALF * K * 2;
    const size_t tstep = 2 * hstep;
    const unsigned ldsw = (unsigned)wid * 1024u;
    const int aoff = lds_byte(wr * 64 + fr, fq * 8), boff = lds_byte(wc * 32 + fr, fq * 8);
#define PG8_SA(b, h) (((b) * 2 + (h)) * HTB)
#define PG8_SB(b, h) ((4 + (b) * 2 + (h)) * HTB)
#define PG8_STAGE(bufoff, gbase, voff) do { _Pragma("unroll") for (int _i = 0; _i < 2; ++_i) \
        __builtin_amdgcn_global_load_lds((const unsigned*)((const char*)(gbase) + (voff)[_i]), (PG8_LAS unsigned*)(lds + (bufoff) + ldsw + _i * 8192), 16, 0, 0); } while (0)
#define PG8_LDA(dst, b, h) do { _Pragma("unroll") for (int m = 0; m < 4; ++m) _Pragma("unroll") for (int k = 0; k < 2; ++k) dst[m][k] = *(const PG8_LAS bf16x8*)(lds + PG8_SA(b, h) + aoff + m * 2048 + k * 1024); } while (0)
#define PG8_LDB(dst, b, h) do { _Pragma("unroll") for (int n = 0; n < 2; ++n) _Pragma("unroll") for (int k = 0; k < 2; ++k) dst[n][k] = *(const PG8_LAS bf16x8*)(lds + PG8_SB(b, h) + boff + n * 2048 + k * 1024); } while (0)
#define PG8_MMA(ai, bj, At, Bt) do { __builtin_amdgcn_s_setprio(1); _Pragma("unroll") for (int m = 0; m < 4; ++m) _Pragma("unroll") for (int n = 0; n < 2; ++n) _Pragma("unroll") for (int k = 0; k < 2; ++k) \
        acc[ai][bj][m][n] = __builtin_amdgcn_mfma_f32_16x16x32_bf16(Bt[n][k], At[m][k], acc[ai][bj][m][n], 0, 0, 0); __builtin_amdgcn_s_setprio(0); } while (0)
#define PG8_WAIT_V(n) asm volatile("s_waitcnt vmcnt(" #n ")" ::: "memory")
#define PG8_WAIT_L(n) asm volatile("s_waitcnt lgkmcnt(" #n ")" ::: "memory")
#define PG8_BAR __builtin_amdgcn_s_barrier()
#define PG8_SCHED __builtin_amdgcn_sched_barrier(0)
    Unit cur, nxt; int ui = 0;
    if (!S.next(0, cur)) return;
    f32x4 acc[2][2][4][2];
#pragma unroll
    for (int a = 0; a < 2; ++a)
#pragma unroll
        for (int b = 0; b < 2; ++b)
#pragma unroll
            for (int m = 0; m < 4; ++m)
#pragma unroll
                for (int n = 0; n < 2; ++n) acc[a][b][m][n] = (f32x4){0.f, 0.f, 0.f, 0.f};
    bf16x8 At[4][2], B0[2][2], B1[2][2];
    const char* cA = (const char*)g.A + (size_t)cur.pm * tstep; const char* cB = (const char*)g.Bt + (size_t)cur.pn * tstep;
    S.a_ready(cur);
    if constexpr (SP2) {
        PG8_STAGE(PG8_SB(0, 0), cB, voffB); PG8_STAGE(PG8_SB(0, 1), cB + hstep, voffB); PG8_STAGE(PG8_SA(0, 0), cA, voffA); PG8_STAGE(PG8_SA(0, 1), cA + hstep, voffA);
        if (wr == 1) PG8_BAR;
        PG8_WAIT_V(2); PG8_BAR;
        PG8_STAGE(PG8_SB(1, 0), cB + kstep, voffB); PG8_STAGE(PG8_SA(1, 0), cA + kstep, voffA); PG8_STAGE(PG8_SB(1, 1), cB + hstep + kstep, voffB);
        PG8_WAIT_V(6); PG8_BAR;
    } else {
        PG8_STAGE(PG8_SB(0, 0), cB, voffB); PG8_STAGE(PG8_SA(0, 0), cA, voffA); PG8_STAGE(PG8_SB(0, 1), cB + hstep, voffB); PG8_STAGE(PG8_SA(0, 1), cA + hstep, voffA);
        if (wr == 1) PG8_BAR;
        PG8_WAIT_V(4); PG8_BAR;
        PG8_STAGE(PG8_SB(1, 0), cB + kstep, voffB); PG8_STAGE(PG8_SA(1, 0), cA + kstep, voffA); PG8_STAGE(PG8_SB(1, 1), cB + hstep + kstep, voffB);
        PG8_WAIT_V(6); PG8_BAR;
    }
    for (;;) {
        const bool has_next = S.next(ui + 1, nxt);
        const char* nA = has_next ? (const char*)g.A + (size_t)nxt.pm * tstep : cA; const char* nB = has_next ? (const char*)g.Bt + (size_t)nxt.pn * tstep : cB;
        for (int t = 0; t < nt; t += 2) {
            const bool last = (t == nt - 2);
            const char* a1 = cA + (size_t)(t + 1) * kstep;
            const char* a2 = last ? nA : cA + (size_t)(t + 2) * kstep; const char* b2 = last ? nB : cB + (size_t)(t + 2) * kstep;
            const char* a3 = a2 + kstep; const char* b3 = b2 + kstep;
            if (last && has_next) S.a_ready(nxt);
            if constexpr (SP2) {
            PG8_LDB(B0, 0, 0); PG8_LDB(B1, 0, 1); PG8_SCHED; PG8_LDA(At, 0, 0); PG8_STAGE(PG8_SA(1, 1), a1 + hstep, voffA);
            PG8_WAIT_V(8); PG8_WAIT_L(0); PG8_BAR; PG8_MMA(0, 0, At, B0); PG8_MMA(0, 1, At, B1); PG8_BAR; PG8_SCHED;
            PG8_LDA(At, 0, 1); PG8_STAGE(PG8_SB(0, 0), b2, voffB); PG8_STAGE(PG8_SB(0, 1), b2 + hstep, voffB); PG8_STAGE(PG8_SA(0, 0), a2, voffA);
            PG8_WAIT_V(8); PG8_WAIT_L(0); PG8_BAR; PG8_MMA(1, 0, At, B0); PG8_MMA(1, 1, At, B1); PG8_BAR; PG8_SCHED;
            PG8_LDB(B0, 1, 0); PG8_LDB(B1, 1, 1); PG8_SCHED; PG8_LDA(At, 1, 0); PG8_STAGE(PG8_SA(0, 1), a2 + hstep, voffA);
            PG8_WAIT_V(8); PG8_WAIT_L(0); PG8_BAR; PG8_MMA(0, 0, At, B0); PG8_MMA(0, 1, At, B1); PG8_BAR; PG8_SCHED;
            PG8_LDA(At, 1, 1); PG8_STAGE(PG8_SB(1, 0), b3, voffB); PG8_STAGE(PG8_SB(1, 1), b3 + hstep, voffB); PG8_STAGE(PG8_SA(1, 0), a3, voffA);
            PG8_WAIT_V(8); PG8_WAIT_L(0); PG8_BAR; PG8_MMA(1, 0, At, B0); PG8_MMA(1, 1, At, B1); PG8_BAR; PG8_SCHED;
            } else {
            PG8_LDB(B0, 0, 0); PG8_SCHED; PG8_LDA(At, 0, 0); PG8_STAGE(PG8_SA(1, 1), a1 + hstep, voffA);
            PG8_WAIT_L(8); PG8_BAR; PG8_WAIT_L(0); PG8_MMA(0, 0, At, B0); PG8_BAR; PG8_SCHED;
            PG8_LDB(B1, 0, 1); PG8_STAGE(PG8_SB(0, 0), b2, voffB);
            PG8_BAR; PG8_WAIT_L(0); PG8_MMA(0, 1, At, B1); PG8_BAR;
            PG8_LDA(At, 0, 1); PG8_STAGE(PG8_SA(0, 0), a2, voffA);
            PG8_BAR; PG8_WAIT_L(0); PG8_MMA(1, 0, At, B0); PG8_BAR; PG8_SCHED;
            PG8_STAGE(PG8_SB(0, 1), b2 + hstep, voffB);
            PG8_WAIT_V(6); PG8_BAR; PG8_MMA(1, 1, At, B1); PG8_BAR;
            PG8_LDB(B0, 1, 0); PG8_SCHED; PG8_LDA(At, 1, 0); PG8_STAGE(PG8_SA(0, 1), a2 + hstep, voffA);
            PG8_WAIT_L(8); PG8_BAR; PG8_WAIT_L(0); PG8_MMA(0, 0, At, B0); PG8_BAR; PG8_SCHED;
            PG8_LDB(B1, 1, 1); PG8_STAGE(PG8_SB(1, 0), b3, voffB);
            PG8_BAR; PG8_WAIT_L(0); PG8_MMA(0, 1, At, B1); PG8_BAR;
            PG8_LDA(At, 1, 1); PG8_STAGE(PG8_SA(1, 0), a3, voffA);
            PG8_BAR; PG8_WAIT_L(0); PG8_MMA(1, 0, At, B0); PG8_BAR; PG8_SCHED;
            PG8_STAGE(PG8_SB(1, 1), b3 + hstep, voffB);
            PG8_WAIT_V(6); PG8_BAR; PG8_MMA(1, 1, At, B1); PG8_BAR;
            }
        }
        if constexpr (ALIGN_EPI) { if (wr == 0) PG8_BAR; }
        if constexpr (!Epi::AFTER_DRAIN) { E(acc, cur, wr, wc, fr, fq); S.done(cur); }
        if (!has_next) break;
#pragma unroll
        for (int a = 0; a < 2; ++a)
#pragma unroll
            for (int b = 0; b < 2; ++b)
#pragma unroll
                for (int m = 0; m < 4; ++m)
#pragma unroll
                    for (int n = 0; n < 2; ++n) acc[a][b][m][n] = (f32x4){0.f, 0.f, 0.f, 0.f};
        cur = nxt; cA = nA; cB = nB; ++ui;
        if constexpr (ALIGN_EPI) { if (wr == 1) PG8_BAR; }
    }
    PG8_WAIT_V(0);
    if constexpr (!ALIGN_EPI) { if (wr == 0) PG8_BAR; }
    PG8_BAR;
    if constexpr (Epi::AFTER_DRAIN) { E.fused(acc, cur, wr, wc, fr, fq, lds, wid, lane); S.done(cur); }
#undef PG8_SA
#undef PG8_SB
#undef PG8_STAGE
#undef PG8_LDA
#undef PG8_LDB
#undef PG8_MMA
#undef PG8_WAIT_V
#undef PG8_WAIT_L
#undef PG8_BAR
#undef PG8_SCHED
}

typedef unsigned u32x2 __attribute__((ext_vector_type(2)));
__device__ __forceinline__ float sigm(float v) { return __builtin_amdgcn_rcpf(1.f + __expf(-v)); }
__device__ __forceinline__ float bf_lo(unsigned w) { return __uint_as_float(w << 16); }
__device__ __forceinline__ float bf_hi(unsigned w) { return __uint_as_float(w & 0xffff0000u); }
constexpr float RMS_EPS_ = 1e-6f;
__device__ __forceinline__ float row_rstd(const float* ssq, int row) {
    const f32x4* p = (const f32x4*)(ssq + (size_t)row * 16);
    const f32x4 a = p[0], b = p[1], c = p[2], d = p[3];
    const float s = ((a[0] + a[1]) + (a[2] + a[3])) + ((b[0] + b[1]) + (b[2] + b[3])) + ((c[0] + c[1]) + (c[2] + c[3])) + ((d[0] + d[1]) + (d[2] + d[3]));
    return 1.0f / sqrtf(s * (1.0f / 1024.0f) + RMS_EPS_);
}

struct EpiProj {
    static constexpr bool PERM = true, AFTER_DRAIN = false;
    bf16_t* O; float qscale;
    __device__ __forceinline__ void operator()(const f32x4 (&acc)[2][2][4][2], const Unit& u, int wr, int wc, int fr, int fq) const {
        const int row0 = u.pm * BM + wr * 64 + fr, colt = u.pn * BM, col0 = colt + wc * 32 + 8 * fq;
        const int mode = (colt >= 2048) ? 2 : ((colt >= 512 && colt < 1024) ? 1 : 0);
#pragma unroll
        for (int ai = 0; ai < 2; ++ai)
#pragma unroll
            for (int m = 0; m < 4; ++m) { bf16_t* rowp = O + (size_t)(row0 + ai * HALF + m * 16) * 4096 + col0;
#pragma unroll
                for (int bj = 0; bj < 2; ++bj) { f32x4 v0 = acc[ai][bj][m][0], v1 = acc[ai][bj][m][1];
                    if (mode == 1) { v0 = v0 * qscale; v1 = v1 * qscale; }
                    if (mode == 2) { v0 = (f32x4){sigm(v0[0]), sigm(v0[1]), sigm(v0[2]), sigm(v0[3])}; v1 = (f32x4){sigm(v1[0]), sigm(v1[1]), sigm(v1[2]), sigm(v1[3])}; }
                    u32x4 w; w.x = cvt_pk_bf16(v0[0], v0[1]); w.y = cvt_pk_bf16(v0[2], v0[3]); w.z = cvt_pk_bf16(v1[0], v1[1]); w.w = cvt_pk_bf16(v1[2], v1[3]);
                    *(u32x4*)(rowp + bj * HALF) = w; } }
    }
};
struct EpiPlain {
    static constexpr bool PERM = true, AFTER_DRAIN = false;
    bf16_t* O; int ldc; const float* ssq; float scale;
    __device__ __forceinline__ void operator()(const f32x4 (&acc)[2][2][4][2], const Unit& u, int wr, int wc, int fr, int fq) const {
        const int row0 = u.pm * BM + wr * 64 + fr, col0 = u.pn * BM + wc * 32 + 8 * fq;
#pragma unroll
        for (int ai = 0; ai < 2; ++ai)
#pragma unroll
            for (int m = 0; m < 4; ++m) { const int row = row0 + ai * HALF + m * 16; bf16_t* rowp = O + (size_t)row * ldc + col0;
                const float sc = ssq ? row_rstd(ssq, row) * scale : scale;
#pragma unroll
                for (int bj = 0; bj < 2; ++bj) { const f32x4 v0 = acc[ai][bj][m][0] * sc, v1 = acc[ai][bj][m][1] * sc;
                    u32x4 w; w.x = cvt_pk_bf16(v0[0], v0[1]); w.y = cvt_pk_bf16(v0[2], v0[3]); w.z = cvt_pk_bf16(v1[0], v1[1]); w.w = cvt_pk_bf16(v1[2], v1[3]);
                    *(u32x4*)(rowp + bj * HALF) = w; } }
    }
};
struct EpiGlu {
    static constexpr bool PERM = false, AFTER_DRAIN = false;
    const bf16_t* proj; bf16_t* mix;
    __device__ __forceinline__ void operator()(const f32x4 (&acc)[2][2][4][2], const Unit& u, int wr, int wc, int fr, int fq) const {
#pragma unroll
        for (int ai = 0; ai < 2; ++ai)
#pragma unroll
            for (int m = 0; m < 4; ++m) { const int row = u.pm * BM + ai * HALF + wr * 64 + m * 16 + fr;
#pragma unroll
                for (int n = 0; n < 2; ++n) { const int ch0 = u.pn * HALF + wc * 32 + 16 * n + 4 * fq;
                    const u32x2 gw = *(const u32x2*)(proj + (size_t)row * 4096 + 2048 + ch0);
                    const f32x4 a = acc[ai][0][m][n], b = acc[ai][1][m][n];
                    const float o0 = bf_lo(gw.x) * a[0] * sigm(b[0]), o1 = bf_hi(gw.x) * a[1] * sigm(b[1]), o2 = bf_lo(gw.y) * a[2] * sigm(b[2]), o3 = bf_hi(gw.y) * a[3] * sigm(b[3]);
                    u32x2 w; w.x = cvt_pk_bf16(o0, o1); w.y = cvt_pk_bf16(o2, o3);
                    *(u32x2*)(mix + (size_t)row * 1024 + ch0) = w; } }
    }
};
struct EpiFoxO {
    static constexpr bool PERM = true, AFTER_DRAIN = false;
    const bf16_t* proj; bf16_t* mix;
    __device__ __forceinline__ void operator()(const f32x4 (&acc)[2][2][4][2], const Unit& u, int wr, int wc, int fr, int fq) const {
        const int row0 = u.pm * BM + wr * 64 + fr, col0 = u.pn * BM + wc * 32 + 8 * fq;
#pragma unroll
        for (int ai = 0; ai < 2; ++ai)
#pragma unroll
            for (int m = 0; m < 4; ++m) { const int row = row0 + ai * HALF + m * 16;
#pragma unroll
                for (int bj = 0; bj < 2; ++bj) { const int ch0 = col0 + bj * HALF;
                    const u32x4 gw = *(const u32x4*)(proj + (size_t)row * 4096 + 3072 + ch0);
                    bf16_t* mp = mix + (size_t)row * 1024 + ch0; const u32x4 mw = *(const u32x4*)mp;
                    const f32x4 v0 = acc[ai][bj][m][0], v1 = acc[ai][bj][m][1];
                    u32x4 w;
                    w.x = cvt_pk_bf16(bf_lo(mw.x) + bf_lo(gw.x) * v0[0], bf_hi(mw.x) + bf_hi(gw.x) * v0[1]);
                    w.y = cvt_pk_bf16(bf_lo(mw.y) + bf_lo(gw.y) * v0[2], bf_hi(mw.y) + bf_hi(gw.y) * v0[3]);
                    w.z = cvt_pk_bf16(bf_lo(mw.z) + bf_lo(gw.z) * v1[0], bf_hi(mw.z) + bf_hi(gw.z) * v1[1]);
                    w.w = cvt_pk_bf16(bf_lo(mw.w) + bf_lo(gw.w) * v1[2], bf_hi(mw.w) + bf_hi(gw.w) * v1[3]);
                    *(u32x4*)mp = w; } }
    }
};
struct EpiRes {
    static constexpr bool PERM = false, AFTER_DRAIN = false;
    const float* res; float* out; bf16_t* hb; float* ssq;
    __device__ __forceinline__ void operator()(const f32x4 (&acc)[2][2][4][2], const Unit& u, int wr, int wc, int fr, int fq) const {
#pragma unroll
        for (int ai = 0; ai < 2; ++ai)
#pragma unroll
            for (int m = 0; m < 4; ++m) { const int row = u.pm * BM + ai * HALF + wr * 64 + m * 16 + fr; float ss = 0.f;
#pragma unroll
                for (int bj = 0; bj < 2; ++bj)
#pragma unroll
                    for (int n = 0; n < 2; ++n) { const size_t off = (size_t)row * 1024 + u.pn * BM + bj * HALF + wc * 32 + 16 * n + 4 * fq;
                        const f32x4 h = *(const f32x4*)(res + off) + acc[ai][bj][m][n];
                        *(f32x4*)(out + off) = h; ss += (h[0] * h[0] + h[1] * h[1]) + (h[2] * h[2] + h[3] * h[3]);
                        if (hb) { u32x2 w; w.x = cvt_pk_bf16(h[0], h[1]); w.y = cvt_pk_bf16(h[2], h[3]); *(u32x2*)(hb + off) = w; } }
                ss += __shfl_xor(ss, 16); ss += __shfl_xor(ss, 32);
                if (fq == 0) ssq[(size_t)row * 16 + u.pn * 4 + wc] = ss; }
    }
};
struct EpiFfn {
    static constexpr bool PERM = false, AFTER_DRAIN = false;
    const float* ssq; bf16_t* hid;
    __device__ __forceinline__ void operator()(const f32x4 (&acc)[2][2][4][2], const Unit& u, int wr, int wc, int fr, int fq) const {
#pragma unroll
        for (int ai = 0; ai < 2; ++ai)
#pragma unroll
            for (int m = 0; m < 4; ++m) { const int row = u.pm * BM + ai * HALF + wr * 64 + m * 16 + fr; const float rs = row_rstd(ssq, row);
#pragma unroll
                for (int n = 0; n < 2; ++n) { const int ch0 = u.pn * HALF + wc * 32 + 16 * n + 4 * fq;
                    const f32x4 a = acc[ai][0][m][n] * rs, b = acc[ai][1][m][n] * rs;
                    u32x2 w; w.x = cvt_pk_bf16(a[0] * sigm(a[0]) * b[0], a[1] * sigm(a[1]) * b[1]); w.y = cvt_pk_bf16(a[2] * sigm(a[2]) * b[2], a[3] * sigm(a[3]) * b[3]);
                    *(u32x2*)(hid + (size_t)row * 2816 + ch0) = w; } }
    }
};
}

#define LAS __attribute__((address_space(3)))
typedef unsigned short bf16_t;
typedef short bf16x8 __attribute__((ext_vector_type(8)));
typedef short s16x4 __attribute__((ext_vector_type(4)));
typedef float f32x4 __attribute__((ext_vector_type(4)));
typedef float f32x16 __attribute__((ext_vector_type(16)));
typedef unsigned u32x4 __attribute__((ext_vector_type(4)));
typedef unsigned u32x2 __attribute__((ext_vector_type(2)));

constexpr int NWAVES = 8, NTHR = 512;
constexpr int BATCH = 2, SEQ = 8192, DM = 1024, M = BATCH * SEQ;
constexpr int NG = 32, NP = 64, NCHUNK = 128, LC = 64;
constexpr int FFH = 2816;
constexpr float LOG2E = 1.4426950408889634f;
constexpr float RMS_EPS = 1e-6f;
constexpr size_t MiB = 1u << 20;
constexpr size_t WS_LAMB = 0, WS_L64 = 16384, WS_BBAR = 65536, WS_CM = 65536 + 262144;
constexpr size_t WS_LF = 1 * MiB, WS_CUM = 1 * MiB + 512 * 1024;
constexpr size_t WS_E = 2 * MiB;
constexpr size_t WS_SSQ1 = 6 * MiB, WS_SSQ2 = 7 * MiB, WS_SSQ3 = 8 * MiB;
constexpr size_t WS_MN = 9 * MiB, WS_KVM = 10 * MiB;
constexpr size_t WS_WIN = 12 * MiB, WS_WGLU = 20 * MiB, WS_WFO = 22 * MiB, WS_WMO = 23 * MiB, WS_WMQ = 25 * MiB, WS_WMKV = 26 * MiB, WS_WMOO = 28 * MiB, WS_WF1 = 29 * MiB, WS_WF2 = 40 * MiB;
constexpr size_t WS_U = 48 * MiB;
constexpr size_t WS_PROJ = 80 * MiB;
constexpr size_t WS_HB = 80 * MiB, WS_QM = 112 * MiB, WS_OM = 128 * MiB, WS_HID = 112 * MiB;
constexpr size_t WS_ATT = 208 * MiB, WS_YSSM = 224 * MiB;
constexpr size_t WS_END = 240 * MiB;
constexpr int LDS_BYTES = 131072 + 1024;

__device__ __forceinline__ unsigned f2bf(float f) { unsigned u = __builtin_bit_cast(unsigned, f); return (u + 0x7fffu + ((u >> 16) & 1u)) >> 16; }
__device__ __forceinline__ unsigned pk2(float lo, float hi) { return f2bf(lo) | (f2bf(hi) << 16); }
__device__ __forceinline__ float bfl(unsigned w) { return __uint_as_float(w << 16); }
__device__ __forceinline__ float bfh(unsigned w) { return __uint_as_float(w & 0xffff0000u); }
__device__ __forceinline__ float wave_sum(float v) {
#pragma unroll
    for (int o = 1; o < 64; o <<= 1) v += __shfl_xor(v, o);
    return v;
}
__device__ __forceinline__ float swap_max(float m) { auto rr = __builtin_amdgcn_permlane32_swap(__float_as_uint(m), __float_as_uint(m), false, false); return fmaxf(__uint_as_float(rr[0]), __uint_as_float(rr[1])); }
__device__ __forceinline__ float swap_sum(float m) { auto rr = __builtin_amdgcn_permlane32_swap(__float_as_uint(m), __float_as_uint(m), false, false); return __uint_as_float(rr[0]) + __uint_as_float(rr[1]); }

struct Args {
    const float* in[25]; float* out; unsigned char* ws; int ph_lo, ph_hi;
};

__device__ __forceinline__ int crow(int r, int hi) { return (r & 3) + 8 * (r >> 2) + 4 * hi; }
typedef short v4i16_t __attribute__((ext_vector_type(4)));
__device__ __forceinline__ s16x4 vtr(LAS const unsigned char* p) { return __builtin_bit_cast(s16x4, __builtin_amdgcn_ds_read_tr16_b64_v4i16((LAS v4i16_t*)p)); }

template <int D, bool FOX>
__device__ __forceinline__ void attn_unit(LAS unsigned char* lds, const bf16_t* Q, const bf16_t* K, const bf16_t* V, bf16_t* O,
                                          int qpitch, int kvpitch, int opitch, int ntiles, const float* cum, int qpos0) {
    constexpr int TB = D * 128;
    constexpr int NPASS = D / 64;
    constexpr int OFF_K = 0, OFF_V = 2 * TB, OFF_CK = 4 * TB, OFF_WS = 4 * TB + 512;
    const int tid = threadIdx.x, lane = tid & 63, r32 = lane & 31, hi = lane >> 5;
    const int wid = __builtin_amdgcn_readfirstlane(tid >> 6);
    LAS float* wsf = (LAS float*)(lds + OFF_WS) + wid * 32;
    bf16x8 qr[D / 16];
    { const bf16_t* qrow = Q + (size_t)(32 * wid + r32) * qpitch + 8 * hi;
#pragma unroll
      for (int d0 = 0; d0 < D / 16; ++d0) qr[d0] = *(const bf16x8*)(qrow + 16 * d0); }
    const int qpos = qpos0 + 32 * wid + r32;
    float cq = 0.f, cref = 0.f;
    if (FOX) { cref = cum[qpos0 + 255]; cq = (cum[qpos] - cref) * LOG2E; }
    f32x16 o[D / 32];
#pragma unroll
    for (int i = 0; i < D / 32; ++i)
#pragma unroll
        for (int r = 0; r < 16; ++r) o[i][r] = 0.f;
    float mrun = -INFINITY, lrun = 0.f;
    u32x4 kreg[NPASS], vreg[NPASS]; float ckreg = 0.f;
#define ATT_LOAD(t) do { _Pragma("unroll") for (int ps = 0; ps < NPASS; ++ps) { const int id = ps * 512 + tid; \
        kreg[ps] = *(const u32x4*)(K + (size_t)(64 * (t) + (id & 63)) * kvpitch + 8 * (id >> 6)); \
        vreg[ps] = *(const u32x4*)(V + (size_t)(64 * (t) + ((id & 255) >> 2)) * kvpitch + 32 * (id >> 8) + 8 * (id & 3)); } \
        if (FOX && tid < 64) ckreg = (cum[64 * (t) + tid] - cref) * LOG2E; } while (0)
#define ATT_WRITE(slot) do { _Pragma("unroll") for (int ps = 0; ps < NPASS; ++ps) { const int id = ps * 512 + tid; \
        *(LAS u32x4*)(lds + OFF_K + (slot) * TB + id * 16) = kreg[ps]; *(LAS u32x4*)(lds + OFF_V + (slot) * TB + id * 16) = vreg[ps]; } \
        if (FOX && tid < 64) *(LAS float*)(lds + OFF_CK + (slot) * 256 + tid * 4) = ckreg; } while (0)
    int cur = 0;
    ATT_LOAD(ntiles - 1); ATT_WRITE(0); __syncthreads();
    const int vbase = (4 * hi + ((lane & 15) >> 2)) * 64 + ((lane >> 4) & 1) * 32 + (lane & 3) * 8;
    for (int t = ntiles - 1; t >= 0; --t) {
        if (t > 0) ATT_LOAD(t - 1);
        const bool active = !FOX || (64 * t <= qpos0 + 32 * wid + 31);
        if (active) {
            LAS const unsigned char* Ks = lds + OFF_K + cur * TB; LAS const unsigned char* Vs = lds + OFF_V + cur * TB;
            f32x16 p0, p1;
#pragma unroll
            for (int r = 0; r < 16; ++r) { p0[r] = 0.f; p1[r] = 0.f; }
#pragma unroll
            for (int d0 = 0; d0 < D / 16; ++d0) {
                const bf16x8 k0 = *(LAS const bf16x8*)(Ks + (2 * d0 + hi) * 1024 + r32 * 16);
                const bf16x8 k1 = *(LAS const bf16x8*)(Ks + (2 * d0 + hi) * 1024 + 512 + r32 * 16);
                p0 = __builtin_amdgcn_mfma_f32_32x32x16_bf16(k0, qr[d0], p0, 0, 0, 0);
                p1 = __builtin_amdgcn_mfma_f32_32x32x16_bf16(k1, qr[d0], p1, 0, 0, 0);
            }
            if (FOX) {
                LAS const float* cks = (LAS const float*)(lds + OFF_CK + cur * 256);
#pragma unroll
                for (int g4 = 0; g4 < 4; ++g4) {
                    const f32x4 c0 = *(LAS const f32x4*)(cks + 8 * g4 + 4 * hi), c1 = *(LAS const f32x4*)(cks + 32 + 8 * g4 + 4 * hi);
#pragma unroll
                    for (int i = 0; i < 4; ++i) { p0[4 * g4 + i] += cq - c0[i]; p1[4 * g4 + i] += cq - c1[i]; }
                }
                if (64 * t + 63 > qpos0 + 32 * wid) {
#pragma unroll
                    for (int r = 0; r < 16; ++r) { const int kv = 64 * t + crow(r, hi); if (kv > qpos) p0[r] = -INFINITY; if (kv + 32 > qpos) p1[r] = -INFINITY; }
                }
            }
            float rm = fmaxf(p0[0], p1[0]);
#pragma unroll
            for (int r = 1; r < 16; ++r) rm = fmaxf(rm, fmaxf(p0[r], p1[r]));
            rm = swap_max(rm);
            if (__any(rm > mrun + 8.0f)) {
                const float mn = fmaxf(mrun, rm), alpha = __builtin_amdgcn_exp2f(mrun - mn);
                lrun *= alpha; mrun = mn;
                if (hi == 0) wsf[r32] = alpha;
#pragma unroll
                for (int g4 = 0; g4 < 4; ++g4) { const f32x4 a4 = *(LAS const f32x4*)(wsf + 8 * g4 + 4 * hi);
#pragma unroll
                    for (int i = 0; i < 4; ++i)
#pragma unroll
                        for (int d0 = 0; d0 < D / 32; ++d0) o[d0][4 * g4 + i] *= a4[i]; }
            }
            float ls = 0.f;
#pragma unroll
            for (int r = 0; r < 16; ++r) { p0[r] = __builtin_amdgcn_exp2f(p0[r] - mrun); p1[r] = __builtin_amdgcn_exp2f(p1[r] - mrun); ls += p0[r] + p1[r]; }
            lrun += ls;
            bf16x8 pa[4];
            { u32x4 w;
              w.x = pk2(p0[0], p0[1]); w.y = pk2(p0[2], p0[3]); w.z = pk2(p0[4], p0[5]); w.w = pk2(p0[6], p0[7]); pa[0] = __builtin_bit_cast(bf16x8, w);
              w.x = pk2(p0[8], p0[9]); w.y = pk2(p0[10], p0[11]); w.z = pk2(p0[12], p0[13]); w.w = pk2(p0[14], p0[15]); pa[1] = __builtin_bit_cast(bf16x8, w);
              w.x = pk2(p1[0], p1[1]); w.y = pk2(p1[2], p1[3]); w.z = pk2(p1[4], p1[5]); w.w = pk2(p1[6], p1[7]); pa[2] = __builtin_bit_cast(bf16x8, w);
              w.x = pk2(p1[8], p1[9]); w.y = pk2(p1[10], p1[11]); w.z = pk2(p1[12], p1[13]); w.w = pk2(p1[14], p1[15]); pa[3] = __builtin_bit_cast(bf16x8, w); }
#pragma unroll
            for (int d0 = 0; d0 < D / 32; ++d0)
#pragma unroll
                for (int ks = 0; ks < 4; ++ks) {
                    const s16x4 lo = vtr(Vs + d0 * 4096 + ks * 1024 + vbase), hh = vtr(Vs + d0 * 4096 + ks * 1024 + 512 + vbase);
                    const bf16x8 vf = (bf16x8){lo[0], lo[1], lo[2], lo[3], hh[0], hh[1], hh[2], hh[3]};
                    o[d0] = __builtin_amdgcn_mfma_f32_32x32x16_bf16(pa[ks], vf, o[d0], 0, 0, 0);
                }
        }
        if (t > 0) ATT_WRITE(cur ^ 1);
        __syncthreads();
        cur ^= 1;
    }
#undef ATT_LOAD
#undef ATT_WRITE
    const float lt = swap_sum(lrun);
    if (hi == 0) wsf[r32] = 1.0f / lt;
#pragma unroll
    for (int g4 = 0; g4 < 4; ++g4) { const f32x4 a4 = *(LAS const f32x4*)(wsf + 8 * g4 + 4 * hi);
#pragma unroll
        for (int i = 0; i < 4; ++i) { const int r = 4 * g4 + i; bf16_t* orow = O + (size_t)(32 * wid + crow(r, hi)) * opitch + r32;
#pragma unroll
            for (int d0 = 0; d0 < D / 32; ++d0) orow[32 * d0] = (bf16_t)f2bf(o[d0][r] * a4[i]); } }
    __syncthreads();
}

__device__ __forceinline__ void ssm_pass1(const unsigned char* ws, int gw, int ngw, int lane) {
    const bf16_t* proj = (const bf16_t*)(ws + WS_PROJ); const float* bbar = (const float*)(ws + WS_BBAR); const float2* lamb = (const float2*)(ws + WS_LAMB);
    float2* E = (float2*)(ws + WS_E);
    for (int it = gw; it < BATCH * NG * NCHUNK; it += ngw) {
        const int c = it & 127, g = (it >> 7) & 31, b = it >> 12;
        float br[16], bi[16];
        { const f32x4* bp = (const f32x4*)(bbar + (size_t)(g * 64 + lane) * 32);
#pragma unroll
          for (int j = 0; j < 4; ++j) { const f32x4 a = bp[j], d = bp[4 + j];
#pragma unroll
              for (int i = 0; i < 4; ++i) { br[4 * j + i] = a[i]; bi[4 * j + i] = d[i]; } } }
        const float2 lam = lamb[g * 64 + lane];
        float xr = 0.f, xi = 0.f;
        const bf16_t* up = proj + (size_t)(b * SEQ + LC * c) * 4096 + 16 * g;
#pragma unroll 4
        for (int s = 0; s < LC; ++s) {
            const u32x4 w0 = *(const u32x4*)(up + (size_t)s * 4096), w1 = *(const u32x4*)(up + (size_t)s * 4096 + 8);
            float u[16];
            u[0] = bfl(w0.x); u[1] = bfh(w0.x); u[2] = bfl(w0.y); u[3] = bfh(w0.y); u[4] = bfl(w0.z); u[5] = bfh(w0.z); u[6] = bfl(w0.w); u[7] = bfh(w0.w);
            u[8] = bfl(w1.x); u[9] = bfh(w1.x); u[10] = bfl(w1.y); u[11] = bfh(w1.y); u[12] = bfl(w1.z); u[13] = bfh(w1.z); u[14] = bfl(w1.w); u[15] = bfh(w1.w);
            float bur = 0.f, bui = 0.f;
#pragma unroll
            for (int n = 0; n < 16; ++n) { bur += br[n] * u[n]; bui += bi[n] * u[n]; }
            const float nr = lam.x * xr - lam.y * xi + bur, ni = lam.x * xi + lam.y * xr + bui;
            xr = nr; xi = ni;
        }
        E[(size_t)it * 64 + lane] = make_float2(xr, xi);
    }
}
__device__ __forceinline__ float gelu_tanh(float v) {
    const float z = 0.7978845608028654f * (v + 0.044715f * v * v * v);
    const float th = 1.0f - 2.0f / (__expf(2.0f * z) + 1.0f);
    return 0.5f * v * (1.0f + th);
}
__device__ __forceinline__ void ssm_pass2(const unsigned char* ws, unsigned char* wsw, const float* dskip, LAS unsigned char* lds, int gw, int ngw, int lane, int wid) {
    const bf16_t* proj = (const bf16_t*)(ws + WS_PROJ); const float* bbar = (const float*)(ws + WS_BBAR); const float2* lamb = (const float2*)(ws + WS_LAMB);
    const float2* l64 = (const float2*)(ws + WS_L64); const float2* E = (const float2*)(ws + WS_E); const bf16_t* cm = (const bf16_t*)(ws + WS_CM);
    bf16_t* yssm = (bf16_t*)(wsw + WS_YSSM);
    LAS unsigned char* xs = lds + wid * 8704;
    const int quad = lane >> 4, l15 = lane & 15;
    for (int it = gw; it < BATCH * NG * NCHUNK; it += ngw) {
        const int c = it & 127, g = (it >> 7) & 31, b = it >> 12;
        float br[16], bi[16];
        { const f32x4* bp = (const f32x4*)(bbar + (size_t)(g * 64 + lane) * 32);
#pragma unroll
          for (int j = 0; j < 4; ++j) { const f32x4 a = bp[j], d = bp[4 + j];
#pragma unroll
              for (int i = 0; i < 4; ++i) { br[4 * j + i] = a[i]; bi[4 * j + i] = d[i]; } } }
        const float2 lam = lamb[g * 64 + lane], lc = l64[g * 64 + lane];
        float xr = 0.f, xi = 0.f;
        { const float2* ep = E + (size_t)(it - c) * 64 + lane;
          for (int j = 0; j < c; ++j) { const float2 e = ep[(size_t)j * 64]; const float nr = lc.x * xr - lc.y * xi + e.x, ni = lc.x * xi + lc.y * xr + e.y; xr = nr; xi = ni; } }
        bf16x8 cb[4];
#pragma unroll
        for (int ks = 0; ks < 4; ++ks) cb[ks] = *(const bf16x8*)(cm + (size_t)(g * 16 + l15) * 128 + 32 * ks + 8 * quad);
        const float dsk = dskip[16 * g + l15];
        const size_t row0 = (size_t)b * SEQ + LC * c;
        const bf16_t* up = proj + row0 * 4096 + 16 * g;
        for (int half = 0; half < 2; ++half) {
#pragma unroll 4
            for (int s = 0; s < 32; ++s) {
                const bf16_t* us = up + (size_t)(32 * half + s) * 4096;
                const u32x4 w0 = *(const u32x4*)us, w1 = *(const u32x4*)(us + 8);
                float u[16];
                u[0] = bfl(w0.x); u[1] = bfh(w0.x); u[2] = bfl(w0.y); u[3] = bfh(w0.y); u[4] = bfl(w0.z); u[5] = bfh(w0.z); u[6] = bfl(w0.w); u[7] = bfh(w0.w);
                u[8] = bfl(w1.x); u[9] = bfh(w1.x); u[10] = bfl(w1.y); u[11] = bfh(w1.y); u[12] = bfl(w1.z); u[13] = bfh(w1.z); u[14] = bfl(w1.w); u[15] = bfh(w1.w);
                float bur = 0.f, bui = 0.f;
#pragma unroll
                for (int n = 0; n < 16; ++n) { bur += br[n] * u[n]; bui += bi[n] * u[n]; }
                const float nr = lam.x * xr - lam.y * xi + bur, ni = lam.x * xi + lam.y * xr + bui;
                xr = nr; xi = ni;
                *(LAS unsigned*)(xs + s * 272 + lane * 4) = pk2(xr, xi);
            }
#pragma unroll
            for (int mt = 0; mt < 2; ++mt) {
                f32x4 acc = (f32x4){0.f, 0.f, 0.f, 0.f};
#pragma unroll
                for (int ks = 0; ks < 4; ++ks) { const bf16x8 a = *(LAS const bf16x8*)(xs + (16 * mt + l15) * 272 + (32 * ks + 8 * quad) * 2);
                    acc = __builtin_amdgcn_mfma_f32_16x16x32_bf16(a, cb[ks], acc, 0, 0, 0); }
#pragma unroll
                for (int j = 0; j < 4; ++j) { const size_t row = row0 + 32 * half + 16 * mt + 4 * quad + j;
                    const float uv = __uint_as_float((unsigned)proj[row * 4096 + 16 * g + l15] << 16);
                    const float y = gelu_tanh(acc[j] + dsk * uv);
                    yssm[row * 512 + 16 * g + l15] = (bf16_t)f2bf(y); }
            }
        }
    }
}

__device__ __forceinline__ void transpose_item(const float* W, int N, int k0, int csrc, bf16_t* WT, int K, int nrow0, const float* gain, LAS float* scr, int lane) {
#pragma unroll 8
    for (int i = 0; i < 32; ++i) { const int kk = 2 * i + (lane >> 5); float v = W[(size_t)(k0 + kk) * N + csrc + (lane & 31)]; if (gain) v *= gain[k0 + kk]; scr[kk * 33 + (lane & 31)] = v; }
    const int c = lane & 7;
#pragma unroll
    for (int j = 0; j < 4; ++j) { const int n = (lane >> 3) + 8 * j; const LAS float* s = scr + (8 * c) * 33 + n;
        u32x4 o; o.x = pk2(s[0 * 33], s[1 * 33]); o.y = pk2(s[2 * 33], s[3 * 33]); o.z = pk2(s[4 * 33], s[5 * 33]); o.w = pk2(s[6 * 33], s[7 * 33]);
        *(u32x4*)(WT + (size_t)(nrow0 + n) * K + k0 + 8 * c) = o; }
}
__device__ __forceinline__ bool transpose_matrix(int& r, const float* W, int K, int N, int Nd, int mode, int half, bf16_t* WT, const float* gain, LAS float* scr, int lane) {
    const int nblk = Nd / 32, items = (K / 64) * nblk;
    if (r >= items) { r -= items; return false; }
    const int kb = r / nblk, nb = r % nblk, n0 = 32 * nb;
    int csrc = n0;
    if (mode == 1) csrc = n0 >= 2048 ? n0 + 8 : n0;
    if (mode == 2) { const int pn = n0 >> 8, bj = (n0 >> 7) & 1, j = n0 & 127; csrc = bj * half + 128 * pn + j; }
    transpose_item(W, N, 64 * kb, csrc, WT, K, n0, gain, scr, lane);
    return true;
}
__device__ __forceinline__ float log_sigmoid(float z) { return fminf(z, 0.f) - log1pf(expf(-fabsf(z))); }

__device__ __forceinline__ void prologue(const Args& A, LAS unsigned char* lds, int gw, int ngw, int lane, int wid) {
    unsigned char* ws = A.ws;
    const float* x = A.in[0]; const float* mem = A.in[1]; const float* norm_mix = A.in[2]; const float* w_in = A.in[3]; const float* b_forget = A.in[4];
    LAS float* wf = (LAS float*)(lds + 98304);
    for (int i = threadIdx.x; i < 8192; i += NTHR) { const int k = i >> 3, h = i & 7; wf[i] = w_in[(size_t)k * 4104 + 2048 + h] * norm_mix[k]; }
    __syncthreads();
    LAS float* scr = (LAS float*)(lds + wid * 8448);
    {
        constexpr int NITEMS = 16 * 128 + 8 * 64 + 8 * 32 + 16 * 32 + 16 * 16 + 16 * 32 + 8 * 32 + 16 * 176 + 44 * 32;
        for (int it = gw; it < NITEMS; it += ngw) {
            int r = it;
            if (transpose_matrix(r, A.in[3], 1024, 4104, 4096, 1, 0, (bf16_t*)(ws + WS_WIN), A.in[2], scr, lane)) continue;
            if (transpose_matrix(r, A.in[13], 512, 2048, 2048, 2, 1024, (bf16_t*)(ws + WS_WGLU), nullptr, scr, lane)) continue;
            if (transpose_matrix(r, A.in[14], 512, 1024, 1024, 0, 0, (bf16_t*)(ws + WS_WFO), nullptr, scr, lane)) continue;
            if (transpose_matrix(r, A.in[15], 1024, 1024, 1024, 0, 0, (bf16_t*)(ws + WS_WMO), nullptr, scr, lane)) continue;
            if (transpose_matrix(r, A.in[18], 1024, 512, 512, 0, 0, (bf16_t*)(ws + WS_WMQ), A.in[16], scr, lane)) continue;
            if (transpose_matrix(r, A.in[19], 1024, 1024, 1024, 0, 0, (bf16_t*)(ws + WS_WMKV), A.in[17], scr, lane)) continue;
            if (transpose_matrix(r, A.in[20], 512, 1024, 1024, 0, 0, (bf16_t*)(ws + WS_WMOO), nullptr, scr, lane)) continue;
            if (transpose_matrix(r, A.in[22], 1024, 5632, 5632, 2, 2816, (bf16_t*)(ws + WS_WF1), A.in[21], scr, lane)) continue;
            transpose_matrix(r, A.in[23], 2816, 1024, 1024, 0, 0, (bf16_t*)(ws + WS_WF2), nullptr, scr, lane);
        }
    }
    {
        bf16_t* U = (bf16_t*)(ws + WS_U); float* LF = (float*)(ws + WS_LF);
        for (int m = gw; m < M; m += ngw) {
            const f32x4* xr = (const f32x4*)(x + (size_t)m * DM) + lane;
            f32x4 v[4]; float s = 0.f;
#pragma unroll
            for (int j = 0; j < 4; ++j) { v[j] = xr[64 * j]; s += (v[j][0] * v[j][0] + v[j][1] * v[j][1]) + (v[j][2] * v[j][2] + v[j][3] * v[j][3]); }
            const float rstd = 1.0f / sqrtf(wave_sum(s) * (1.0f / DM) + RMS_EPS);
            float f[8];
#pragma unroll
            for (int h = 0; h < 8; ++h) f[h] = 0.f;
#pragma unroll
            for (int j = 0; j < 4; ++j)
#pragma unroll
                for (int i = 0; i < 4; ++i) { const int k = 256 * j + 4 * lane + i; const f32x4 wa = *(LAS const f32x4*)(wf + k * 8), wb = *(LAS const f32x4*)(wf + k * 8 + 4); const float xv = v[j][i];
                    f[0] += xv * wa[0]; f[1] += xv * wa[1]; f[2] += xv * wa[2]; f[3] += xv * wa[3]; f[4] += xv * wb[0]; f[5] += xv * wb[1]; f[6] += xv * wb[2]; f[7] += xv * wb[3]; }
            float mine = 0.f;
#pragma unroll
            for (int h = 0; h < 8; ++h) { const float t = wave_sum(f[h]); if (lane == h) mine = t; }
            if (lane < 8) { const int b = m >> 13, t = m & 8191; LF[(size_t)(b * 8 + lane) * SEQ + t] = log_sigmoid(mine * rstd + b_forget[lane]); }
            u32x2* o8 = (u32x2*)(U + (size_t)m * DM) + lane;
#pragma unroll
            for (int j = 0; j < 4; ++j) { u32x2 w; w.x = pk2(v[j][0] * rstd, v[j][1] * rstd); w.y = pk2(v[j][2] * rstd, v[j][3] * rstd); o8[64 * j] = w; }
        }
    }
    {
        bf16_t* MN = (bf16_t*)(ws + WS_MN);
        for (int m = gw; m < BATCH * 256; m += ngw) {
            const f32x4* xr = (const f32x4*)(mem + (size_t)m * DM) + lane;
            f32x4 v[4]; float s = 0.f;
#pragma unroll
            for (int j = 0; j < 4; ++j) { v[j] = xr[64 * j]; s += (v[j][0] * v[j][0] + v[j][1] * v[j][1]) + (v[j][2] * v[j][2] + v[j][3] * v[j][3]); }
            const float rstd = 1.0f / sqrtf(wave_sum(s) * (1.0f / DM) + RMS_EPS);
            u32x2* o8 = (u32x2*)(MN + (size_t)m * DM) + lane;
#pragma unroll
            for (int j = 0; j < 4; ++j) { u32x2 w; w.x = pk2(v[j][0] * rstd, v[j][1] * rstd); w.y = pk2(v[j][2] * rstd, v[j][3] * rstd); o8[64 * j] = w; }
        }
    }
    if (gw < NG) {
        const int g = gw, p = lane, gp = g * 64 + p;
        const float* lam_re = A.in[5]; const float* lam_im = A.in[6]; const float* log_dt = A.in[7];
        const float* b_re = A.in[8]; const float* b_im = A.in[9]; const float* c_re = A.in[10]; const float* c_im = A.in[11];
        const float lr = lam_re[gp], li = lam_im[gp], dt = expf(log_dt[g]);
        const float mag = expf(lr * dt); float sn, cs; sincosf(li * dt, &sn, &cs);
        const float ar = mag * cs, ai = mag * sn;
        ((float2*)(ws + WS_LAMB))[gp] = make_float2(ar, ai);
        float pr = ar, pi = ai;
#pragma unroll
        for (int q = 0; q < 6; ++q) { const float nr = pr * pr - pi * pi, ni = 2.f * pr * pi; pr = nr; pi = ni; }
        ((float2*)(ws + WS_L64))[gp] = make_float2(pr, pi);
        const float den = lr * lr + li * li, nr_ = ar - 1.0f;
        const float cr = (nr_ * lr + ai * li) / den, ci = (ai * lr - nr_ * li) / den;
        float* bb = (float*)(ws + WS_BBAR) + (size_t)gp * 32;
#pragma unroll
        for (int n = 0; n < 16; ++n) { const float br = b_re[(size_t)gp * 16 + n], bi = b_im[(size_t)gp * 16 + n]; bb[n] = cr * br - ci * bi; bb[16 + n] = cr * bi + ci * br; }
        bf16_t* cmat = (bf16_t*)(ws + WS_CM);
#pragma unroll
        for (int n = 0; n < 16; ++n) { const size_t ci_ = (size_t)(g * 16 + n) * 64 + p;
            *(unsigned*)(cmat + (size_t)(g * 16 + n) * 128 + 2 * p) = pk2(c_re[ci_], -c_im[ci_]); }
    }
}

__device__ __forceinline__ void cumsum_seq(const float* lf, float* cum, int lane) {
    const float* p = lf + 128 * lane; double s = 0.0;
    for (int i = 0; i < 128; ++i) s += (double)p[i];
    double incl = s;
#pragma unroll
    for (int o = 1; o < 64; o <<= 1) { const double t = __shfl_up(incl, o); if (lane >= o) incl += t; }
    double run = incl - s;
    float* q = cum + 128 * lane;
    for (int i = 0; i < 128; ++i) { run += (double)p[i]; q[i] = (float)run; }
}

__global__ void __launch_bounds__(NTHR, 2) fwd_kernel(Args args) {
    extern __shared__ __attribute__((aligned(16))) unsigned char lds_raw[];
    LAS unsigned char* lds = (LAS unsigned char*)lds_raw;
    cg::grid_group grid = cg::this_grid();
    const int tid = threadIdx.x, lane = tid & 63, wid = __builtin_amdgcn_readfirstlane(tid >> 6);
    const int G = gridDim.x, bx = blockIdx.x;
    const int vcu = (G % 8 == 0) ? (bx % 8) * (G / 8) + bx / 8 : bx;
    const int gw = vcu * NWAVES + wid, ngw = G * NWAVES;
    unsigned char* ws = args.ws;
    const int lo = args.ph_lo, hi = args.ph_hi;
#define IN(k) (lo <= (k) && (k) < hi)
#define SEAM(k) do { if (IN(k) && IN((k) + 1)) grid.sync(); } while (0)
    bf16_t* PROJ = (bf16_t*)(ws + WS_PROJ); bf16_t* MIX = (bf16_t*)(ws + WS_U); bf16_t* HB = (bf16_t*)(ws + WS_HB);

    if (IN(0)) { prologue(args, lds, gw, ngw, lane, wid); }
    SEAM(0);
    if (IN(1)) {
        if (bx < 16 && wid == 0) cumsum_seq((const float*)(ws + WS_LF) + (size_t)bx * SEQ, (float*)(ws + WS_CUM) + (size_t)bx * SEQ, lane);
        pg8::Gemm g{(const bf16_t*)(ws + WS_U), (const bf16_t*)(ws + WS_WIN), M, 4096, 1024}; pg8::StaticOrder S; S.init(M, 4096, G, bx);
        pg8::EpiProj E{PROJ, 0.125f * LOG2E};
        pg8::gemm_phase<pg8::EpiProj, pg8::StaticOrder, true, true>(lds, g, S, E);
    }
    SEAM(1);
    if (IN(2)) {
        ssm_pass1(ws, gw, ngw, lane);
        const int bh = vcu >> 4, s = vcu & 15;
        if (bh < 16) {
            const int b = bh >> 3, h = bh & 7;
#pragma unroll 1
            for (int i = 0; i < 2; ++i) { const int qb = i == 0 ? 31 - s : s;
                const size_t qrow = (size_t)b * SEQ + 256 * qb;
                attn_unit<64, true>(lds, PROJ + qrow * 4096 + 512 + 64 * h, PROJ + (size_t)b * SEQ * 4096 + 1024 + 64 * h, PROJ + (size_t)b * SEQ * 4096 + 1536 + 64 * h,
                                    (bf16_t*)(ws + WS_ATT) + qrow * 512 + 64 * h, 4096, 4096, 512, 4 * qb + 4, (const float*)(ws + WS_CUM) + (size_t)bh * SEQ, 256 * qb); }
        }
    }
    SEAM(2);
    if (IN(3)) { ssm_pass2(ws, ws, args.in[12], lds, gw, ngw, lane, wid); }
    SEAM(3);
    if (IN(4)) {
        pg8::Gemm g{(const bf16_t*)(ws + WS_YSSM), (const bf16_t*)(ws + WS_WGLU), M, 2048, 512}; pg8::StaticOrder S; S.init(M, 2048, G, bx);
        pg8::EpiGlu E{PROJ, MIX};
        pg8::gemm_phase<pg8::EpiGlu, pg8::StaticOrder, true, true>(lds, g, S, E);
    }
    SEAM(4);
    if (IN(5)) {
        pg8::Gemm g{(const bf16_t*)(ws + WS_ATT), (const bf16_t*)(ws + WS_WFO), M, 1024, 512}; pg8::StaticOrder S; S.init(M, 1024, G, bx);
        pg8::EpiFoxO E{PROJ, MIX};
        pg8::gemm_phase<pg8::EpiFoxO, pg8::StaticOrder, true, true>(lds, g, S, E);
    }
    SEAM(5);
    if (IN(6)) {
        pg8::Gemm g{MIX, (const bf16_t*)(ws + WS_WMO), M, 1024, 1024}; pg8::StaticOrder S; S.init(M, 1024, G, bx);
        pg8::EpiRes E{args.in[0], args.out, HB, (float*)(ws + WS_SSQ1)};
        pg8::gemm_phase<pg8::EpiRes, pg8::StaticOrder, true, true>(lds, g, S, E);
    }
    SEAM(6);
    if (IN(7)) {
        if (bx < 128) {
            pg8::Gemm g{HB, (const bf16_t*)(ws + WS_WMQ), M, 512, 1024}; pg8::StaticOrder S; S.init(M, 512, G, bx);
            pg8::EpiPlain E{(bf16_t*)(ws + WS_QM), 512, (const float*)(ws + WS_SSQ1), 0.08838834764831845f * LOG2E};
            pg8::gemm_phase<pg8::EpiPlain, pg8::StaticOrder, true, true>(lds, g, S, E);
        } else {
            pg8::Gemm g{(const bf16_t*)(ws + WS_MN), (const bf16_t*)(ws + WS_WMKV), 512, 1024, 1024}; pg8::StaticOrder S; S.init(512, 1024, G, bx - 128);
            pg8::EpiPlain E{(bf16_t*)(ws + WS_KVM), 1024, nullptr, 1.0f};
            pg8::gemm_phase<pg8::EpiPlain, pg8::StaticOrder, true, true>(lds, g, S, E);
        }
    }
    SEAM(7);
    if (IN(8)) {
        for (int un = vcu; un < 256; un += G) { const int qb = un & 31, hm = (un >> 5) & 3, b = un >> 7;
            const size_t qrow = (size_t)b * SEQ + 256 * qb; const bf16_t* kv = (const bf16_t*)(ws + WS_KVM) + (size_t)b * 256 * 1024;
            attn_unit<128, false>(lds, (const bf16_t*)(ws + WS_QM) + qrow * 512 + 128 * hm, kv + 128 * hm, kv + 512 + 128 * hm,
                                  (bf16_t*)(ws + WS_OM) + qrow * 512 + 128 * hm, 512, 1024, 512, 4, nullptr, 0); }
    }
    SEAM(8);
    if (IN(9)) {
        pg8::Gemm g{(const bf16_t*)(ws + WS_OM), (const bf16_t*)(ws + WS_WMOO), M, 1024, 512}; pg8::StaticOrder S; S.init(M, 1024, G, bx);
        pg8::EpiRes E{args.out, args.out, HB, (float*)(ws + WS_SSQ2)};
        pg8::gemm_phase<pg8::EpiRes, pg8::StaticOrder, true, true>(lds, g, S, E);
    }
    SEAM(9);
    if (IN(10)) {
        pg8::Gemm g{HB, (const bf16_t*)(ws + WS_WF1), M, 2 * FFH, 1024}; pg8::StaticOrder S; S.init(M, 2 * FFH, G, bx);
        pg8::EpiFfn E{(const float*)(ws + WS_SSQ2), (bf16_t*)(ws + WS_HID)};
        pg8::gemm_phase<pg8::EpiFfn, pg8::StaticOrder, true, true>(lds, g, S, E);
    }
    SEAM(10);
    if (IN(11)) {
        pg8::Gemm g{(const bf16_t*)(ws + WS_HID), (const bf16_t*)(ws + WS_WF2), M, 1024, FFH}; pg8::StaticOrder S; S.init(M, 1024, G, bx);
        pg8::EpiRes E{args.out, args.out, nullptr, (float*)(ws + WS_SSQ3)};
        pg8::gemm_phase<pg8::EpiRes, pg8::StaticOrder, true, true>(lds, g, S, E);
    }
    SEAM(11);
    if (IN(12)) {
        const float* gn = args.in[24]; const float* ssq = (const float*)(ws + WS_SSQ3);
        for (int m = gw; m < M; m += ngw) {
            const float rs = pg8::row_rstd(ssq, m);
            f32x4* xr = (f32x4*)(args.out + (size_t)m * DM) + lane; const f32x4* gr = (const f32x4*)gn + lane;
#pragma unroll
            for (int j = 0; j < 4; ++j) { const f32x4 v = xr[64 * j] * rs * gr[64 * j]; xr[64 * j] = v; }
        }
    }
#undef IN
#undef SEAM
}

constexpr int NPHASE = 13;
extern "C" void kernel_launch(void* const* d_in, const int* in_sizes, int n_in, void* d_out, int out_size, void* d_ws, size_t ws_size, hipStream_t stream) {
    static int grid = 0;
    if (grid == 0) {
        if (n_in != 25 || out_size != M * DM || ws_size < WS_END) { fprintf(stderr, "kernel_launch: unexpected shapes (n_in %d out %d ws %zu)\n", n_in, out_size, ws_size); grid = -1; return; }
        int dev = 0, cus = 0, per_cu = 0;
        (void)hipGetDevice(&dev); (void)hipDeviceGetAttribute(&cus, hipDeviceAttributeMultiprocessorCount, dev);
        if (hipFuncSetAttribute((const void*)fwd_kernel, hipFuncAttributeMaxDynamicSharedMemorySize, LDS_BYTES) != hipSuccess) { fprintf(stderr, "kernel_launch: hipFuncSetAttribute failed\n"); grid = -1; return; }
        if (hipOccupancyMaxActiveBlocksPerMultiprocessor(&per_cu, (const void*)fwd_kernel, NTHR, LDS_BYTES) != hipSuccess || per_cu < 1) fprintf(stderr, "kernel_launch: occupancy query says %d\n", per_cu);
        (void)hipGetLastError();
        grid = cus > 0 ? cus : 256;
    }
    if (grid < 0) return;
    Args a{};
    for (int i = 0; i < 25; ++i) a.in[i] = (const float*)d_in[i];
    a.out = (float*)d_out; a.ws = (unsigned char*)d_ws;
#if MK_ONE_LAUNCH
    a.ph_lo = 0; a.ph_hi = NPHASE;
    void* kargs[] = {&a};
    hipError_t e = hipLaunchCooperativeKernel((const void*)fwd_kernel, dim3(grid), dim3(NTHR), kargs, LDS_BYTES, stream);
    if (e != hipSuccess) fprintf(stderr, "cooperative launch failed: %s (grid %d)\n", hipGetErrorString(e), grid);
#else
    for (int ph = 0; ph < NPHASE; ++ph) { a.ph_lo = ph; a.ph_hi = ph + 1; hipLaunchKernelGGL(fwd_kernel, dim3(grid), dim3(NTHR), LDS_BYTES, stream, a); }
#endif
}
```

```cpp
#include <hip/hip_runtime.h>
#include <hip/hip_cooperative_groups.h>
#include <cstdio>
#include <cstdint>
#include <cmath>
namespace cg = cooperative_groups;

#ifndef MK_ONE_LAUNCH
#define MK_ONE_LAUNCH 1
#endif
#ifndef REP_ATT
#define REP_ATT 1
#endif
#ifndef REP_SSM1
#define REP_SSM1 1
#endif
#ifndef REP_SSM2
#define REP_SSM2 1
#endif
#ifndef REP_PRO
#define REP_PRO 1
#endif
#ifndef REP_PROW
#define REP_PROW 1
#endif
#ifndef REP_PROX
#define REP_PROX 1
#endif
#ifndef REP_G1
#define REP_G1 1
#endif
#ifndef REP_G7
#define REP_G7 1
#endif
#ifndef REP_MATT
#define REP_MATT 1
#endif
#ifndef REP_SYNC
#define REP_SYNC 1
#endif
#undef MK_ONE_LAUNCH
#define MK_ONE_LAUNCH 1
namespace pg8 {
#define PG8_LAS __attribute__((address_space(3)))
typedef unsigned short bf16_t;
typedef short bf16x8 __attribute__((ext_vector_type(8)));
typedef float f32x4 __attribute__((ext_vector_type(4)));
typedef unsigned u32x4 __attribute__((ext_vector_type(4)));
constexpr int BM = 256, BK = 64, HALF = 128, HTB = HALF * BK * 2  , STAGE_BYTES = 8 * HTB, NXCD = 8, WGM = 8;

__host__ __device__ __forceinline__ int lds_byte(int r, int c) { const int st = (r >> 4) * 2 + (c >> 5), rr = r & 15, cc = c & 31, ob = rr * 64 + cc * 2; return st * 1024 + (ob ^ (((ob >> 9) & 1) << 5)); }
__host__ __device__ __forceinline__ void stage_rc(int b, int& R, int& C) { const int st = b / 1024, sb = b % 1024, swz = sb ^ (((sb >> 9) & 1) << 5); R = (st >> 1) * 16 + swz / 64; C = (st & 1) * 32 + (swz % 64) / 2; }
__host__ __device__ __forceinline__ int perm32(int rho) { const int n = rho >> 4, i = rho & 15; return 8 * (i >> 2) + 4 * n + (i & 3); }

struct Unit { int pm, pn; };
struct Gemm { const bf16_t* A; const bf16_t* Bt; int M, N, K; };

struct StaticOrder {
    int nM, nN, nwg, G, c;
    __host__ __device__ void init(int M, int N, int G_, int c_) { nM = M / BM; nN = N / BM; nwg = nM * nN; G = G_; c = c_; }
    __host__ __device__ bool next(int i, Unit& u) const {
        const long L = (long)i * G + c; if (L >= nwg) return false;
        int wgid = (int)L; { const int q = nwg / NXCD, r = nwg % NXCD, xcd = wgid % NXCD, off = wgid / NXCD; wgid = (xcd < r ? xcd * (q + 1) : r * (q + 1) + (xcd - r) * q) + off; }
        const int nig = WGM * nN, gid = wgid / nig, fm = gid * WGM, gsz = (nM - fm) < WGM ? (nM - fm) : WGM;
        u.pm = fm + ((wgid % nig) % gsz); u.pn = (wgid % nig) / gsz; return true;
    }
    __device__ __forceinline__ void a_ready(const Unit&) const {}
    __device__ __forceinline__ void done(const Unit&) const {}
};

__device__ __forceinline__ unsigned cvt_pk_bf16(float lo, float hi) { unsigned r; asm volatile("v_cvt_pk_bf16_f32 %0, %1, %2" : "=v"(r) : "v"(lo), "v"(hi)); return r; }
typedef float f32x2 __attribute__((ext_vector_type(2)));
template <class Epi, class Sched, bool ALIGN_EPI = false, bool SP2 = false>
__device__ __forceinline__ void gemm_phase(PG8_LAS unsigned char* lds, const Gemm g, const Sched& S, const Epi& E) {
    const int tid = threadIdx.x, wid = __builtin_amdgcn_readfirstlane(tid >> 6), lane = tid & 63, wr = wid >> 2, wc = wid & 3, fr = lane & 15, fq = lane >> 4;
    const int K = g.K, nt = K / BK;
    unsigned voffA[2], voffB[2];
#pragma unroll
    for (int i = 0; i < 2; ++i) { int R, C; stage_rc(tid * 16 + i * 8192, R, C); const int Rb = Epi::PERM ? ((R & ~31) + perm32(R & 31)) : R;
        voffA[i] = (unsigned)(R * K + C) * 2u; voffB[i] = (unsigned)(Rb * K + C) * 2u; }
    const size_t kstep = (size_t)(BK * 2);
    const size_t hstep = (size_t)HALF * K * 2;
    const size_t tstep = 2 * hstep;
    const unsigned ldsw = (unsigned)wid * 1024u;
    const int aoff = lds_byte(wr * 64 + fr, fq * 8), boff = lds_byte(wc * 32 + fr, fq * 8);
#define PG8_SA(b, h) (((b) * 2 + (h)) * HTB)
#define PG8_SB(b, h) ((4 + (b) * 2 + (h)) * HTB)
#define PG8_STAGE(bufoff, gbase, voff) do { _Pragma("unroll") for (int _i = 0; _i < 2; ++_i) \
        __builtin_amdgcn_global_load_lds((const unsigned*)((const char*)(gbase) + (voff)[_i]), (PG8_LAS unsigned*)(lds + (bufoff) + ldsw + _i * 8192), 16, 0, 0); } while (0)
#define PG8_LDA(dst, b, h) do { _Pragma("unroll") for (int m = 0; m < 4; ++m) _Pragma("unroll") for (int k = 0; k < 2; ++k) dst[m][k] = *(const PG8_LAS bf16x8*)(lds + PG8_SA(b, h) + aoff + m * 2048 + k * 1024); } while (0)
#define PG8_LDB(dst, b, h) do { _Pragma("unroll") for (int n = 0; n < 2; ++n) _Pragma("unroll") for (int k = 0; k < 2; ++k) dst[n][k] = *(const PG8_LAS bf16x8*)(lds + PG8_SB(b, h) + boff + n * 2048 + k * 1024); } while (0)
#define PG8_MMA(ai, bj, At, Bt) do { __builtin_amdgcn_s_setprio(1); _Pragma("unroll") for (int m = 0; m < 4; ++m) _Pragma("unroll") for (int n = 0; n < 2; ++n) _Pragma("unroll") for (int k = 0; k < 2; ++k) \
        acc[ai][bj][m][n] = __builtin_amdgcn_mfma_f32_16x16x32_bf16(Bt[n][k], At[m][k], acc[ai][bj][m][n], 0, 0, 0); __builtin_amdgcn_s_setprio(0); } while (0)
#define PG8_WAIT_V(n) asm volatile("s_waitcnt vmcnt(" #n ")" ::: "memory")
#define PG8_WAIT_L(n) asm volatile("s_waitcnt lgkmcnt(" #n ")" ::: "memory")
#define PG8_BAR __builtin_amdgcn_s_barrier()
#define PG8_SCHED __builtin_amdgcn_sched_barrier(0)
    Unit cur, nxt; int ui = 0;
    if (!S.next(0, cur)) return;
    f32x4 acc[2][2][4][2];
#pragma unroll
    for (int a = 0; a < 2; ++a)
#pragma unroll
        for (int b = 0; b < 2; ++b)
#pragma unroll
            for (int m = 0; m < 4; ++m)
#pragma unroll
                for (int n = 0; n < 2; ++n) acc[a][b][m][n] = (f32x4){0.f, 0.f, 0.f, 0.f};
    bf16x8 At[4][2], B0[2][2], B1[2][2];
    const char* cA = (const char*)g.A + (size_t)cur.pm * tstep; const char* cB = (const char*)g.Bt + (size_t)cur.pn * tstep;
    S.a_ready(cur);
    if constexpr (SP2) {
        PG8_STAGE(PG8_SB(0, 0), cB, voffB); PG8_STAGE(PG8_SB(0, 1), cB + hstep, voffB); PG8_STAGE(PG8_SA(0, 0), cA, voffA); PG8_STAGE(PG8_SA(0, 1), cA + hstep, voffA);
        if (wr == 1) PG8_BAR;
        PG8_WAIT_V(2); PG8_BAR;
        PG8_STAGE(PG8_SB(1, 0), cB + kstep, voffB); PG8_STAGE(PG8_SA(1, 0), cA + kstep, voffA); PG8_STAGE(PG8_SB(1, 1), cB + hstep + kstep, voffB);
        PG8_WAIT_V(6); PG8_BAR;
    } else {
        PG8_STAGE(PG8_SB(0, 0), cB, voffB); PG8_STAGE(PG8_SA(0, 0), cA, voffA); PG8_STAGE(PG8_SB(0, 1), cB + hstep, voffB); PG8_STAGE(PG8_SA(0, 1), cA + hstep, voffA);
        if (wr == 1) PG8_BAR;
        PG8_WAIT_V(4); PG8_BAR;
        PG8_STAGE(PG8_SB(1, 0), cB + kstep, voffB); PG8_STAGE(PG8_SA(1, 0), cA + kstep, voffA); PG8_STAGE(PG8_SB(1, 1), cB + hstep + kstep, voffB);
        PG8_WAIT_V(6); PG8_BAR;
    }
    for (;;) {
        const bool has_next = S.next(ui + 1, nxt);
        const char* nA = has_next ? (const char*)g.A + (size_t)nxt.pm * tstep : cA; const char* nB = has_next ? (const char*)g.Bt + (size_t)nxt.pn * tstep : cB;
        for (int t = 0; t < nt; t += 2) {
            const bool last = (t == nt - 2);
            const char* a1 = cA + (size_t)(t + 1) * kstep;
            const char* a2 = last ? nA : cA + (size_t)(t + 2) * kstep; const char* b2 = last ? nB : cB + (size_t)(t + 2) * kstep;
            const char* a3 = a2 + kstep; const char* b3 = b2 + kstep;
            if (last && has_next) S.a_ready(nxt);
            if constexpr (SP2) {
            PG8_LDB(B0, 0, 0); PG8_LDB(B1, 0, 1); PG8_SCHED; PG8_LDA(At, 0, 0); PG8_STAGE(PG8_SA(1, 1), a1 + hstep, voffA);
            PG8_WAIT_V(8); PG8_WAIT_L(0); PG8_BAR; PG8_MMA(0, 0, At, B0); PG8_MMA(0, 1, At, B1); PG8_BAR; PG8_SCHED;
            PG8_LDA(At, 0, 1); PG8_STAGE(PG8_SB(0, 0), b2, voffB); PG8_STAGE(PG8_SB(0, 1), b2 + hstep, voffB); PG8_STAGE(PG8_SA(0, 0), a2, voffA);
            PG8_WAIT_V(8); PG8_WAIT_L(0); PG8_BAR; PG8_MMA(1, 0, At, B0); PG8_MMA(1, 1, At, B1); PG8_BAR; PG8_SCHED;
            PG8_LDB(B0, 1, 0); PG8_LDB(B1, 1, 1); PG8_SCHED; PG8_LDA(At, 1, 0); PG8_STAGE(PG8_SA(0, 1), a2 + hstep, voffA);
            PG8_WAIT_V(8); PG8_WAIT_L(0); PG8_BAR; PG8_MMA(0, 0, At, B0); PG8_MMA(0, 1, At, B1); PG8_BAR; PG8_SCHED;
            PG8_LDA(At, 1, 1); PG8_STAGE(PG8_SB(1, 0), b3, voffB); PG8_STAGE(PG8_SB(1, 1), b3 + hstep, voffB); PG8_STAGE(PG8_SA(1, 0), a3, voffA);
            PG8_WAIT_V(8); PG8_WAIT_L(0); PG8_BAR; PG8_MMA(1, 0, At, B0); PG8_MMA(1, 1, At, B1); PG8_BAR; PG8_SCHED;
            } else {
            PG8_LDB(B0, 0, 0); PG8_SCHED; PG8_LDA(At, 0, 0); PG8_STAGE(PG8_SA(1, 1), a1 + hstep, voffA);
            PG8_WAIT_L(8); PG8_BAR; PG8_WAIT_L(0); PG8_MMA(0, 0, At, B0); PG8_BAR; PG8_SCHED;
            PG8_LDB(B1, 0, 1); PG8_STAGE(PG8_SB(0, 0), b2, voffB);
            PG8_BAR; PG8_WAIT_L(0); PG8_MMA(0, 1, At, B1); PG8_BAR;
            PG8_LDA(At, 0, 1); PG8_STAGE(PG8_SA(0, 0), a2, voffA);
            PG8_BAR; PG8_WAIT_L(0); PG8_MMA(1, 0, At, B0); PG8_BAR; PG8_SCHED;
            PG8_STAGE(PG8_SB(0, 1), b2 + hstep, voffB);
            PG8_WAIT_V(6); PG8_BAR; PG8_MMA(1, 1, At, B1); PG8_BAR;
            PG8_LDB(B0, 1, 0); PG8_SCHED; PG8_LDA(At, 1, 0); PG8_STAGE(PG8_SA(0, 1), a2 + hstep, voffA);
            PG8_WAIT_L(8); PG8_BAR; PG8_WAIT_L(0); PG8_MMA(0, 0, At, B0); PG8_BAR; PG8_SCHED;
            PG8_LDB(B1, 1, 1); PG8_STAGE(PG8_SB(1, 0), b3, voffB);
            PG8_BAR; PG8_WAIT_L(0); PG8_MMA(0, 1, At, B1); PG8_BAR;
            PG8_LDA(At, 1, 1); PG8_STAGE(PG8_SA(1, 0), a3, voffA);
            PG8_BAR; PG8_WAIT_L(0); PG8_MMA(1, 0, At, B0); PG8_BAR; PG8_SCHED;
            PG8_STAGE(PG8_SB(1, 1), b3 + hstep, voffB);
            PG8_WAIT_V(6); PG8_BAR; PG8_MMA(1, 1, At, B1); PG8_BAR;
            }
        }
        if constexpr (ALIGN_EPI) { if (wr == 0) PG8_BAR; }
        if constexpr (!Epi::AFTER_DRAIN) { E(acc, cur, wr, wc, fr, fq); S.done(cur); }
        if (!has_next) break;
#pragma unroll
        for (int a = 0; a < 2; ++a)
#pragma unroll
            for (int b = 0; b < 2; ++b)
#pragma unroll
                for (int m = 0; m < 4; ++m)
#pragma unroll
                    for (int n = 0; n < 2; ++n) acc[a][b][m][n] = (f32x4){0.f, 0.f, 0.f, 0.f};
        cur = nxt; cA = nA; cB = nB; ++ui;
        if constexpr (ALIGN_EPI) { if (wr == 1) PG8_BAR; }
    }
    PG8_WAIT_V(0);
    if constexpr (!ALIGN_EPI) { if (wr == 0) PG8_BAR; }
    PG8_BAR;
    if constexpr (Epi::AFTER_DRAIN) { E.fused(acc, cur, wr, wc, fr, fq, lds, wid, lane); S.done(cur); }
#undef PG8_SA
#undef PG8_SB
#undef PG8_STAGE
#undef PG8_LDA
#undef PG8_LDB
#undef PG8_MMA
#undef PG8_WAIT_V
#undef PG8_WAIT_L
#undef PG8_BAR
#undef PG8_SCHED
}

typedef unsigned u32x2 __attribute__((ext_vector_type(2)));
__device__ __forceinline__ float sigm(float v) { return __builtin_amdgcn_rcpf(1.f + __expf(-v)); }
__device__ __forceinline__ float bf_lo(unsigned w) { return __uint_as_float(w << 16); }
__device__ __forceinline__ float bf_hi(unsigned w) { return __uint_as_float(w & 0xffff0000u); }
constexpr float RMS_EPS_ = 1e-6f;
__device__ __forceinline__ float row_rstd(const float* ssq, int row) {
    const f32x4* p = (const f32x4*)(ssq + (size_t)row * 16);
    const f32x4 a = p[0], b = p[1], c = p[2], d = p[3];
    const float s = ((a[0] + a[1]) + (a[2] + a[3])) + ((b[0] + b[1]) + (b[2] + b[3])) + ((c[0] + c[1]) + (c[2] + c[3])) + ((d[0] + d[1]) + (d[2] + d[3]));
    return 1.0f / sqrtf(s * (1.0f / 1024.0f) + RMS_EPS_);
}

struct EpiProj {
    static constexpr bool PERM = true, AFTER_DRAIN = false;
    bf16_t* O; float qscale;
    __device__ __forceinline__ void operator()(const f32x4 (&acc)[2][2][4][2], const Unit& u, int wr, int wc, int fr, int fq) const {
        const int row0 = u.pm * BM + wr * 64 + fr, colt = u.pn * BM, col0 = colt + wc * 32 + 8 * fq;
        const int mode = (colt >= 2048) ? 2 : ((colt >= 512 && colt < 1024) ? 1 : 0);
#pragma unroll
        for (int ai = 0; ai < 2; ++ai)
#pragma unroll
            for (int m = 0; m < 4; ++m) { bf16_t* rowp = O + (size_t)(row0 + ai * HALF + m * 16) * 4096 + col0;
#pragma unroll
                for (int bj = 0; bj < 2; ++bj) { f32x4 v0 = acc[ai][bj][m][0], v1 = acc[ai][bj][m][1];
                    if (mode == 1) { v0 = v0 * qscale; v1 = v1 * qscale; }
                    if (mode == 2) { v0 = (f32x4){sigm(v0[0]), sigm(v0[1]), sigm(v0[2]), sigm(v0[3])}; v1 = (f32x4){sigm(v1[0]), sigm(v1[1]), sigm(v1[2]), sigm(v1[3])}; }
                    u32x4 w; w.x = cvt_pk_bf16(v0[0], v0[1]); w.y = cvt_pk_bf16(v0[2], v0[3]); w.z = cvt_pk_bf16(v1[0], v1[1]); w.w = cvt_pk_bf16(v1[2], v1[3]);
                    *(u32x4*)(rowp + bj * HALF) = w; } }
    }
};
struct EpiPlain {
    static constexpr bool PERM = true, AFTER_DRAIN = false;
    bf16_t* O; int ldc; const float* ssq; float scale;
    __device__ __forceinline__ void operator()(const f32x4 (&acc)[2][2][4][2], const Unit& u, int wr, int wc, int fr, int fq) const {
        const int row0 = u.pm * BM + wr * 64 + fr, col0 = u.pn * BM + wc * 32 + 8 * fq;
#pragma unroll
        for (int ai = 0; ai < 2; ++ai)
#pragma unroll
            for (int m = 0; m < 4; ++m) { const int row = row0 + ai * HALF + m * 16; bf16_t* rowp = O + (size_t)row * ldc + col0;
                const float sc = ssq ? row_rstd(ssq, row) * scale : scale;
#pragma unroll
                for (int bj = 0; bj < 2; ++bj) { const f32x4 v0 = acc[ai][bj][m][0] * sc, v1 = acc[ai][bj][m][1] * sc;
                    u32x4 w; w.x = cvt_pk_bf16(v0[0], v0[1]); w.y = cvt_pk_bf16(v0[2], v0[3]); w.z = cvt_pk_bf16(v1[0], v1[1]); w.w = cvt_pk_bf16(v1[2], v1[3]);
                    *(u32x4*)(rowp + bj * HALF) = w; } }
    }
};
struct EpiGlu {
    static constexpr bool PERM = false, AFTER_DRAIN = false;
    const bf16_t* proj; bf16_t* mix;
    __device__ __forceinline__ void operator()(const f32x4 (&acc)[2][2][4][2], const Unit& u, int wr, int wc, int fr, int fq) const {
#pragma unroll
        for (int ai = 0; ai < 2; ++ai)
#pragma unroll
            for (int m = 0; m < 4; ++m) { const int row = u.pm * BM + ai * HALF + wr * 64 + m * 16 + fr;
#pragma unroll
                for (int n = 0; n < 2; ++n) { const int ch0 = u.pn * HALF + wc * 32 + 16 * n + 4 * fq;
                    const u32x2 gw = *(const u32x2*)(proj + (size_t)row * 4096 + 2048 + ch0);
                    const f32x4 a = acc[ai][0][m][n], b = acc[ai][1][m][n];
                    const float o0 = bf_lo(gw.x) * a[0] * sigm(b[0]), o1 = bf_hi(gw.x) * a[1] * sigm(b[1]), o2 = bf_lo(gw.y) * a[2] * sigm(b[2]), o3 = bf_hi(gw.y) * a[3] * sigm(b[3]);
                    u32x2 w; w.x = cvt_pk_bf16(o0, o1); w.y = cvt_pk_bf16(o2, o3);
                    *(u32x2*)(mix + (size_t)row * 1024 + ch0) = w; } }
    }
};
struct EpiFoxO {
    static constexpr bool PERM = true, AFTER_DRAIN = false;
    const bf16_t* proj; bf16_t* mix;
    __device__ __forceinline__ void operator()(const f32x4 (&acc)[2][2][4][2], const Unit& u, int wr, int wc, int fr, int fq) const {
        const int row0 = u.pm * BM + wr * 64 + fr, col0 = u.pn * BM + wc * 32 + 8 * fq;
#pragma unroll
        for (int ai = 0; ai < 2; ++ai)
#pragma unroll
            for (int m = 0; m < 4; ++m) { const int row = row0 + ai * HALF + m * 16;
#pragma unroll
                for (int bj = 0; bj < 2; ++bj) { const int ch0 = col0 + bj * HALF;
                    const u32x4 gw = *(const u32x4*)(proj + (size_t)row * 4096 + 3072 + ch0);
                    bf16_t* mp = mix + (size_t)row * 1024 + ch0; const u32x4 mw = *(const u32x4*)mp;
                    const f32x4 v0 = acc[ai][bj][m][0], v1 = acc[ai][bj][m][1];
                    u32x4 w;
                    w.x = cvt_pk_bf16(bf_lo(mw.x) + bf_lo(gw.x) * v0[0], bf_hi(mw.x) + bf_hi(gw.x) * v0[1]);
                    w.y = cvt_pk_bf16(bf_lo(mw.y) + bf_lo(gw.y) * v0[2], bf_hi(mw.y) + bf_hi(gw.y) * v0[3]);
                    w.z = cvt_pk_bf16(bf_lo(mw.z) + bf_lo(gw.z) * v1[0], bf_hi(mw.z) + bf_hi(gw.z) * v1[1]);
                    w.w = cvt_pk_bf16(bf_lo(mw.w) + bf_lo(gw.w) * v1[2], bf_hi(mw.w) + bf_hi(gw.w) * v1[3]);
                    *(u32x4*)mp = w; } }
    }
};
struct EpiRes {
    static constexpr bool PERM = false, AFTER_DRAIN = false;
    const float* res; float* out; bf16_t* hb; float* ssq;
    __device__ __forceinline__ void operator()(const f32x4 (&acc)[2][2][4][2], const Unit& u, int wr, int wc, int fr, int fq) const {
#pragma unroll
        for (int ai = 0; ai < 2; ++ai)
#pragma unroll
            for (int m = 0; m < 4; ++m) { const int row = u.pm * BM + ai * HALF + wr * 64 + m * 16 + fr; float ss = 0.f;
#pragma unroll
                for (int bj = 0; bj < 2; ++bj)
#pragma unroll
                    for (int n = 0; n < 2; ++n) { const size_t off = (size_t)row * 1024 + u.pn * BM + bj * HALF + wc * 32 + 16 * n + 4 * fq;
                        const f32x4 h = *(const f32x4*)(res + off) + acc[ai][bj][m][n];
                        *(f32x4*)(out + off) = h; ss += (h[0] * h[0] + h[1] * h[1]) + (h[2] * h[2] + h[3] * h[3]);
                        if (hb) { u32x2 w; w.x = cvt_pk_bf16(h[0], h[1]); w.y = cvt_pk_bf16(h[2], h[3]); *(u32x2*)(hb + off) = w; } }
                ss += __shfl_xor(ss, 16); ss += __shfl_xor(ss, 32);
                if (fq == 0) ssq[(size_t)row * 16 + u.pn * 4 + wc] = ss; }
    }
};
struct EpiFfn {
    static constexpr bool PERM = false, AFTER_DRAIN = false;
    const float* ssq; bf16_t* hid;
    __device__ __forceinline__ void operator()(const f32x4 (&acc)[2][2][4][2], const Unit& u, int wr, int wc, int fr, int fq) const {
#pragma unroll
        for (int ai = 0; ai < 2; ++ai)
#pragma unroll
            for (int m = 0; m < 4; ++m) { const int row = u.pm * BM + ai * HALF + wr * 64 + m * 16 + fr; const float rs = row_rstd(ssq, row);
#pragma unroll
                for (int n = 0; n < 2; ++n) { const int ch0 = u.pn * HALF + wc * 32 + 16 * n + 4 * fq;
                    const f32x4 a = acc[ai][0][m][n] * rs, b = acc[ai][1][m][n] * rs;
                    u32x2 w; w.x = cvt_pk_bf16(a[0] * sigm(a[0]) * b[0], a[1] * sigm(a[1]) * b[1]); w.y = cvt_pk_bf16(a[2] * sigm(a[2]) * b[2], a[3] * sigm(a[3]) * b[3]);
                    *(u32x2*)(hid + (size_t)row * 2816 + ch0) = w; } }
    }
};
}

#define LAS __attribute__((address_space(3)))
typedef unsigned short bf16_t;
typedef short bf16x8 __attribute__((ext_vector_type(8)));
typedef short s16x4 __attribute__((ext_vector_type(4)));
typedef float f32x4 __attribute__((ext_vector_type(4)));
typedef float f32x16 __attribute__((ext_vector_type(16)));
typedef unsigned u32x4 __attribute__((ext_vector_type(4)));
typedef unsigned u32x2 __attribute__((ext_vector_type(2)));

constexpr int NWAVES = 8, NTHR = 512;
constexpr int BATCH = 2, SEQ = 8192, DM = 1024, M = BATCH * SEQ;
constexpr int NG = 32, NP = 64, NCHUNK = 128, LC = 64;
constexpr int FFH = 2816;
constexpr float LOG2E = 1.4426950408889634f;
constexpr float RMS_EPS = 1e-6f;
constexpr size_t MiB = 1u << 20;
constexpr size_t WS_LAMB = 0, WS_L64 = 16384, WS_BBAR = 65536, WS_CM = 65536 + 262144;
constexpr size_t WS_BAR = 491520, BAR_BYTES = 16384;
constexpr size_t WS_LF = 1 * MiB, WS_CUM = 1 * MiB + 512 * 1024;
constexpr size_t WS_E = 2 * MiB;
constexpr size_t WS_SSQ1 = 6 * MiB, WS_SSQ2 = 7 * MiB, WS_SSQ3 = 8 * MiB;
constexpr size_t WS_MN = 9 * MiB, WS_KVM = 10 * MiB;
constexpr size_t WS_WIN = 12 * MiB, WS_WGLU = 20 * MiB, WS_WFO = 22 * MiB, WS_WMO = 23 * MiB, WS_WMQ = 25 * MiB, WS_WMKV = 26 * MiB, WS_WMOO = 28 * MiB, WS_WF1 = 29 * MiB, WS_WF2 = 40 * MiB;
constexpr size_t WS_U = 48 * MiB;
constexpr size_t WS_PROJ = 80 * MiB;
constexpr size_t WS_HB = 80 * MiB, WS_QM = 112 * MiB, WS_OM = 128 * MiB, WS_HID = 112 * MiB;
constexpr size_t WS_ATT = 208 * MiB, WS_YSSM = 224 * MiB;
constexpr size_t WS_END = 240 * MiB;
constexpr int LDS_BYTES = 131072 + 1024;

__device__ __forceinline__ unsigned f2bf(float f) { unsigned u = __builtin_bit_cast(unsigned, f); return (u + 0x7fffu + ((u >> 16) & 1u)) >> 16; }
__device__ __forceinline__ unsigned pk2(float lo, float hi) { return f2bf(lo) | (f2bf(hi) << 16); }
__device__ __forceinline__ float bfl(unsigned w) { return __uint_as_float(w << 16); }
__device__ __forceinline__ float bfh(unsigned w) { return __uint_as_float(w & 0xffff0000u); }
__device__ __forceinline__ float wave_sum(float v) {
#pragma unroll
    for (int o = 1; o < 64; o <<= 1) v += __shfl_xor(v, o);
    return v;
}
__device__ __forceinline__ float swap_max(float m) { auto rr = __builtin_amdgcn_permlane32_swap(__float_as_uint(m), __float_as_uint(m), false, false); return fmaxf(__uint_as_float(rr[0]), __uint_as_float(rr[1])); }
__device__ __forceinline__ float swap_sum(float m) { auto rr = __builtin_amdgcn_permlane32_swap(__float_as_uint(m), __float_as_uint(m), false, false); return __uint_as_float(rr[0]) + __uint_as_float(rr[1]); }

struct Args {
    const float* in[25]; float* out; unsigned char* ws; int ph_lo, ph_hi;
};

__device__ __forceinline__ int crow(int r, int hi) { return (r & 3) + 8 * (r >> 2) + 4 * hi; }
typedef short v4i16_t __attribute__((ext_vector_type(4)));
__device__ __forceinline__ s16x4 vtr(LAS const unsigned char* p) { return __builtin_bit_cast(s16x4, __builtin_amdgcn_ds_read_tr16_b64_v4i16((LAS v4i16_t*)p)); }

template <int D, bool FOX>
__device__ __forceinline__ void attn_unit(LAS unsigned char* lds, const bf16_t* Q, const bf16_t* K, const bf16_t* V, bf16_t* O,
                                          int qpitch, int kvpitch, int opitch, int ntiles, const float* cum, int qpos0) {
    constexpr int TB = D * 128;
    constexpr int NPASS = D / 64;
    constexpr int OFF_K = 0, OFF_V = 2 * TB, OFF_CK = 4 * TB, OFF_WS = 4 * TB + 512;
    const int tid = threadIdx.x, lane = tid & 63, r32 = lane & 31, hi = lane >> 5;
    const int wid = __builtin_amdgcn_readfirstlane(tid >> 6);
    LAS float* wsf = (LAS float*)(lds + OFF_WS) + wid * 32;
    bf16x8 qr[D / 16];
    { const bf16_t* qrow = Q + (size_t)(32 * wid + r32) * qpitch + 8 * hi;
#pragma unroll
      for (int d0 = 0; d0 < D / 16; ++d0) qr[d0] = *(const bf16x8*)(qrow + 16 * d0); }
    const int qpos = qpos0 + 32 * wid + r32;
    float cq = 0.f, cref = 0.f;
    if (FOX) { cref = cum[qpos0 + 255]; cq = (cum[qpos] - cref) * LOG2E; }
    f32x16 o[D / 32];
#pragma unroll
    for (int i = 0; i < D / 32; ++i)
#pragma unroll
        for (int r = 0; r < 16; ++r) o[i][r] = 0.f;
    float mrun = -INFINITY, lrun = 0.f;
    u32x4 kreg[NPASS], vreg[NPASS]; float ckreg = 0.f;
#define ATT_LOAD(t) do { _Pragma("unroll") for (int ps = 0; ps < NPASS; ++ps) { const int id = ps * 512 + tid; \
        kreg[ps] = *(const u32x4*)(K + (size_t)(64 * (t) + (id & 63)) * kvpitch + 8 * (id >> 6)); \
        vreg[ps] = *(const u32x4*)(V + (size_t)(64 * (t) + ((id & 255) >> 2)) * kvpitch + 32 * (id >> 8) + 8 * (id & 3)); } \
        if (FOX && tid < 64) ckreg = (cum[64 * (t) + tid] - cref) * LOG2E; } while (0)
#define ATT_WRITE(slot) do { _Pragma("unroll") for (int ps = 0; ps < NPASS; ++ps) { const int id = ps * 512 + tid; \
        *(LAS u32x4*)(lds + OFF_K + (slot) * TB + id * 16) = kreg[ps]; *(LAS u32x4*)(lds + OFF_V + (slot) * TB + id * 16) = vreg[ps]; } \
        if (FOX && tid < 64) *(LAS float*)(lds + OFF_CK + (slot) * 256 + tid * 4) = ckreg; } while (0)
    int cur = 0;
    ATT_LOAD(ntiles - 1); ATT_WRITE(0); __syncthreads();
    const int vbase = (4 * hi + ((lane & 15) >> 2)) * 64 + ((lane >> 4) & 1) * 32 + (lane & 3) * 8;
    for (int t = ntiles - 1; t >= 0; --t) {
        if (t > 0) ATT_LOAD(t - 1);
        const bool active = !FOX || (64 * t <= qpos0 + 32 * wid + 31);
        if (active) {
            LAS const unsigned char* Ks = lds + OFF_K + cur * TB; LAS const unsigned char* Vs = lds + OFF_V + cur * TB;
            f32x16 p0, p1;
#pragma unroll
            for (int r = 0; r < 16; ++r) { p0[r] = 0.f; p1[r] = 0.f; }
#pragma unroll
            for (int d0 = 0; d0 < D / 16; ++d0) {
                const bf16x8 k0 = *(LAS const bf16x8*)(Ks + (2 * d0 + hi) * 1024 + r32 * 16);
                const bf16x8 k1 = *(LAS const bf16x8*)(Ks + (2 * d0 + hi) * 1024 + 512 + r32 * 16);
                p0 = __builtin_amdgcn_mfma_f32_32x32x16_bf16(k0, qr[d0], p0, 0, 0, 0);
                p1 = __builtin_amdgcn_mfma_f32_32x32x16_bf16(k1, qr[d0], p1, 0, 0, 0);
            }
            if (FOX) {
                LAS const float* cks = (LAS const float*)(lds + OFF_CK + cur * 256);
#pragma unroll
                for (int g4 = 0; g4 < 4; ++g4) {
                    const f32x4 c0 = *(LAS const f32x4*)(cks + 8 * g4 + 4 * hi), c1 = *(LAS const f32x4*)(cks + 32 + 8 * g4 + 4 * hi);
#pragma unroll
                    for (int i = 0; i < 4; ++i) { p0[4 * g4 + i] += cq - c0[i]; p1[4 * g4 + i] += cq - c1[i]; }
                }
                if (64 * t + 63 > qpos0 + 32 * wid) {
#pragma unroll
                    for (int r = 0; r < 16; ++r) { const int kv = 64 * t + crow(r, hi); if (kv > qpos) p0[r] = -INFINITY; if (kv + 32 > qpos) p1[r] = -INFINITY; }
                }
            }
            float rm = fmaxf(p0[0], p1[0]);
#pragma unroll
            for (int r = 1; r < 16; ++r) rm = fmaxf(rm, fmaxf(p0[r], p1[r]));
            rm = swap_max(rm);
            if (__any(rm > mrun + 8.0f)) {
                const float mn = fmaxf(mrun, rm), alpha = __builtin_amdgcn_exp2f(mrun - mn);
                lrun *= alpha; mrun = mn;
                if (hi == 0) wsf[r32] = alpha;
#pragma unroll
                for (int g4 = 0; g4 < 4; ++g4) { const f32x4 a4 = *(LAS const f32x4*)(wsf + 8 * g4 + 4 * hi);
#pragma unroll
                    for (int i = 0; i < 4; ++i)
#pragma unroll
                        for (int d0 = 0; d0 < D / 32; ++d0) o[d0][4 * g4 + i] *= a4[i]; }
            }
            float ls = 0.f;
#pragma unroll
            for (int r = 0; r < 16; ++r) { p0[r] = __builtin_amdgcn_exp2f(p0[r] - mrun); p1[r] = __builtin_amdgcn_exp2f(p1[r] - mrun); ls += p0[r] + p1[r]; }
            lrun += ls;
            bf16x8 pa[4];
            { u32x4 w;
              w.x = pk2(p0[0], p0[1]); w.y = pk2(p0[2], p0[3]); w.z = pk2(p0[4], p0[5]); w.w = pk2(p0[6], p0[7]); pa[0] = __builtin_bit_cast(bf16x8, w);
              w.x = pk2(p0[8], p0[9]); w.y = pk2(p0[10], p0[11]); w.z = pk2(p0[12], p0[13]); w.w = pk2(p0[14], p0[15]); pa[1] = __builtin_bit_cast(bf16x8, w);
              w.x = pk2(p1[0], p1[1]); w.y = pk2(p1[2], p1[3]); w.z = pk2(p1[4], p1[5]); w.w = pk2(p1[6], p1[7]); pa[2] = __builtin_bit_cast(bf16x8, w);
              w.x = pk2(p1[8], p1[9]); w.y = pk2(p1[10], p1[11]); w.z = pk2(p1[12], p1[13]); w.w = pk2(p1[14], p1[15]); pa[3] = __builtin_bit_cast(bf16x8, w); }
#pragma unroll
            for (int d0 = 0; d0 < D / 32; ++d0)
#pragma unroll
                for (int ks = 0; ks < 4; ++ks) {
                    const s16x4 lo = vtr(Vs + d0 * 4096 + ks * 1024 + vbase), hh = vtr(Vs + d0 * 4096 + ks * 1024 + 512 + vbase);
                    const bf16x8 vf = (bf16x8){lo[0], lo[1], lo[2], lo[3], hh[0], hh[1], hh[2], hh[3]};
                    o[d0] = __builtin_amdgcn_mfma_f32_32x32x16_bf16(pa[ks], vf, o[d0], 0, 0, 0);
                }
        }
        if (t > 0) ATT_WRITE(cur ^ 1);
        __syncthreads();
        cur ^= 1;
    }
#undef ATT_LOAD
#undef ATT_WRITE
    const float lt = swap_sum(lrun);
    if (hi == 0) wsf[r32] = 1.0f / lt;
#pragma unroll
    for (int g4 = 0; g4 < 4; ++g4) { const f32x4 a4 = *(LAS const f32x4*)(wsf + 8 * g4 + 4 * hi);
#pragma unroll
        for (int i = 0; i < 4; ++i) { const int r = 4 * g4 + i; bf16_t* orow = O + (size_t)(32 * wid + crow(r, hi)) * opitch + r32;
#pragma unroll
            for (int d0 = 0; d0 < D / 32; ++d0) orow[32 * d0] = (bf16_t)f2bf(o[d0][r] * a4[i]); } }
    __syncthreads();
}

__device__ __forceinline__ void ssm_pass1(const unsigned char* ws, int gw, int ngw, int lane) {
    const bf16_t* proj = (const bf16_t*)(ws + WS_PROJ); const float* bbar = (const float*)(ws + WS_BBAR); const float2* lamb = (const float2*)(ws + WS_LAMB);
    float2* E = (float2*)(ws + WS_E);
    for (int it = gw; it < BATCH * NG * NCHUNK; it += ngw) {
        const int c = it & 127, g = (it >> 7) & 31, b = it >> 12;
        float br[16], bi[16];
        { const f32x4* bp = (const f32x4*)(bbar + (size_t)(g * 64 + lane) * 32);
#pragma unroll
          for (int j = 0; j < 4; ++j) { const f32x4 a = bp[j], d = bp[4 + j];
#pragma unroll
              for (int i = 0; i < 4; ++i) { br[4 * j + i] = a[i]; bi[4 * j + i] = d[i]; } } }
        const float2 lam = lamb[g * 64 + lane];
        float xr = 0.f, xi = 0.f;
        const bf16_t* up = proj + (size_t)(b * SEQ + LC * c) * 4096 + 16 * g;
#pragma unroll 4
        for (int s = 0; s < LC; ++s) {
            const u32x4 w0 = *(const u32x4*)(up + (size_t)s * 4096), w1 = *(const u32x4*)(up + (size_t)s * 4096 + 8);
            float u[16];
            u[0] = bfl(w0.x); u[1] = bfh(w0.x); u[2] = bfl(w0.y); u[3] = bfh(w0.y); u[4] = bfl(w0.z); u[5] = bfh(w0.z); u[6] = bfl(w0.w); u[7] = bfh(w0.w);
            u[8] = bfl(w1.x); u[9] = bfh(w1.x); u[10] = bfl(w1.y); u[11] = bfh(w1.y); u[12] = bfl(w1.z); u[13] = bfh(w1.z); u[14] = bfl(w1.w); u[15] = bfh(w1.w);
            float bur = 0.f, bui = 0.f;
#pragma unroll
            for (int n = 0; n < 16; ++n) { bur += br[n] * u[n]; bui += bi[n] * u[n]; }
            const float nr = lam.x * xr - lam.y * xi + bur, ni = lam.x * xi + lam.y * xr + bui;
            xr = nr; xi = ni;
        }
        E[(size_t)it * 64 + lane] = make_float2(xr, xi);
    }
}
__device__ __forceinline__ float gelu_tanh(float v) {
    const float z = 0.7978845608028654f * (v + 0.044715f * v * v * v);
    const float th = 1.0f - 2.0f / (__expf(2.0f * z) + 1.0f);
    return 0.5f * v * (1.0f + th);
}
__device__ __forceinline__ void ssm_pass2(const unsigned char* ws, unsigned char* wsw, const float* dskip, LAS unsigned char* lds, int gw, int ngw, int lane, int wid) {
    const bf16_t* proj = (const bf16_t*)(ws + WS_PROJ); const float* bbar = (const float*)(ws + WS_BBAR); const float2* lamb = (const float2*)(ws + WS_LAMB);
    const float2* l64 = (const float2*)(ws + WS_L64); const float2* E = (const float2*)(ws + WS_E); const bf16_t* cm = (const bf16_t*)(ws + WS_CM);
    bf16_t* yssm = (bf16_t*)(wsw + WS_YSSM);
    LAS unsigned char* xs = lds + wid * 8704;
    const int quad = lane >> 4, l15 = lane & 15;
    for (int it = gw; it < BATCH * NG * NCHUNK; it += ngw) {
        const int c = it & 127, g = (it >> 7) & 31, b = it >> 12;
        float br[16], bi[16];
        { const f32x4* bp = (const f32x4*)(bbar + (size_t)(g * 64 + lane) * 32);
#pragma unroll
          for (int j = 0; j < 4; ++j) { const f32x4 a = bp[j], d = bp[4 + j];
#pragma unroll
              for (int i = 0; i < 4; ++i) { br[4 * j + i] = a[i]; bi[4 * j + i] = d[i]; } } }
        const float2 lam = lamb[g * 64 + lane], lc = l64[g * 64 + lane];
        float xr = 0.f, xi = 0.f;
        { const float2* ep = E + (size_t)(it - c) * 64 + lane;
          for (int j = 0; j < c; ++j) { const float2 e = ep[(size_t)j * 64]; const float nr = lc.x * xr - lc.y * xi + e.x, ni = lc.x * xi + lc.y * xr + e.y; xr = nr; xi = ni; } }
        bf16x8 cb[4];
#pragma unroll
        for (int ks = 0; ks < 4; ++ks) cb[ks] = *(const bf16x8*)(cm + (size_t)(g * 16 + l15) * 128 + 32 * ks + 8 * quad);
        const float dsk = dskip[16 * g + l15];
        const size_t row0 = (size_t)b * SEQ + LC * c;
        const bf16_t* up = proj + row0 * 4096 + 16 * g;
        for (int half = 0; half < 2; ++half) {
#pragma unroll 4
            for (int s = 0; s < 32; ++s) {
                const bf16_t* us = up + (size_t)(32 * half + s) * 4096;
                const u32x4 w0 = *(const u32x4*)us, w1 = *(const u32x4*)(us + 8);
                float u[16];
                u[0] = bfl(w0.x); u[1] = bfh(w0.x); u[2] = bfl(w0.y); u[3] = bfh(w0.y); u[4] = bfl(w0.z); u[5] = bfh(w0.z); u[6] = bfl(w0.w); u[7] = bfh(w0.w);
                u[8] = bfl(w1.x); u[9] = bfh(w1.x); u[10] = bfl(w1.y); u[11] = bfh(w1.y); u[12] = bfl(w1.z); u[13] = bfh(w1.z); u[14] = bfl(w1.w); u[15] = bfh(w1.w);
                float bur = 0.f, bui = 0.f;
#pragma unroll
                for (int n = 0; n < 16; ++n) { bur += br[n] * u[n]; bui += bi[n] * u[n]; }
                const float nr = lam.x * xr - lam.y * xi + bur, ni = lam.x * xi + lam.y * xr + bui;
                xr = nr; xi = ni;
                *(LAS unsigned*)(xs + s * 272 + lane * 4) = pk2(xr, xi);
            }
#pragma unroll
            for (int mt = 0; mt < 2; ++mt) {
                f32x4 acc = (f32x4){0.f, 0.f, 0.f, 0.f};
#pragma unroll
                for (int ks = 0; ks < 4; ++ks) { const bf16x8 a = *(LAS const bf16x8*)(xs + (16 * mt + l15) * 272 + (32 * ks + 8 * quad) * 2);
                    acc = __builtin_amdgcn_mfma_f32_16x16x32_bf16(a, cb[ks], acc, 0, 0, 0); }
#pragma unroll
                for (int j = 0; j < 4; ++j) { const size_t row = row0 + 32 * half + 16 * mt + 4 * quad + j;
                    const float uv = __uint_as_float((unsigned)proj[row * 4096 + 16 * g + l15] << 16);
                    const float y = gelu_tanh(acc[j] + dsk * uv);
                    yssm[row * 512 + 16 * g + l15] = (bf16_t)f2bf(y); }
            }
        }
    }
}

__device__ __forceinline__ void transpose_item(const float* W, int N, int k0, int csrc, bf16_t* WT, int K, int nrow0, const float* gain, LAS float* scr, int lane) {
#pragma unroll 8
    for (int i = 0; i < 32; ++i) { const int kk = 2 * i + (lane >> 5); float v = W[(size_t)(k0 + kk) * N + csrc + (lane & 31)]; if (gain) v *= gain[k0 + kk]; scr[kk * 33 + (lane & 31)] = v; }
    const int c = lane & 7;
#pragma unroll
    for (int j = 0; j < 4; ++j) { const int n = (lane >> 3) + 8 * j; const LAS float* s = scr + (8 * c) * 33 + n;
        u32x4 o; o.x = pk2(s[0 * 33], s[1 * 33]); o.y = pk2(s[2 * 33], s[3 * 33]); o.z = pk2(s[4 * 33], s[5 * 33]); o.w = pk2(s[6 * 33], s[7 * 33]);
        *(u32x4*)(WT + (size_t)(nrow0 + n) * K + k0 + 8 * c) = o; }
}
__device__ __forceinline__ bool transpose_matrix(int& r, const float* W, int K, int N, int Nd, int mode, int half, bf16_t* WT, const float* gain, LAS float* scr, int lane) {
    const int nblk = Nd / 32, items = (K / 64) * nblk;
    if (r >= items) { r -= items; return false; }
    const int kb = r / nblk, nb = r % nblk, n0 = 32 * nb;
    int csrc = n0;
    if (mode == 1) csrc = n0 >= 2048 ? n0 + 8 : n0;
    if (mode == 2) { const int pn = n0 >> 8, bj = (n0 >> 7) & 1, j = n0 & 127; csrc = bj * half + 128 * pn + j; }
    transpose_item(W, N, 64 * kb, csrc, WT, K, n0, gain, scr, lane);
    return true;
}
__device__ __forceinline__ float log_sigmoid(float z) { return fminf(z, 0.f) - log1pf(expf(-fabsf(z))); }

__device__ __forceinline__ void prologue(const Args& A, LAS unsigned char* lds, int gw, int ngw, int lane, int wid) {
    unsigned char* ws = A.ws;
    const float* x = A.in[0]; const float* mem = A.in[1]; const float* norm_mix = A.in[2]; const float* w_in = A.in[3]; const float* b_forget = A.in[4];
    LAS float* wf = (LAS float*)(lds + 98304);
    for (int i = threadIdx.x; i < 8192; i += NTHR) { const int k = i >> 3, h = i & 7; wf[i] = w_in[(size_t)k * 4104 + 2048 + h] * norm_mix[k]; }
    __syncthreads();
    LAS float* scr = (LAS float*)(lds + wid * 8448);
    {
        constexpr int NITEMS = 16 * 128 + 8 * 64 + 8 * 32 + 16 * 32 + 16 * 16 + 16 * 32 + 8 * 32 + 16 * 176 + 44 * 32;
        for (int it = gw; it < NITEMS * REP_PROW; it += ngw) {
            int r = it % NITEMS;
            if (transpose_matrix(r, A.in[3], 1024, 4104, 4096, 1, 0, (bf16_t*)(ws + WS_WIN), A.in[2], scr, lane)) continue;
            if (transpose_matrix(r, A.in[13], 512, 2048, 2048, 2, 1024, (bf16_t*)(ws + WS_WGLU), nullptr, scr, lane)) continue;
            if (transpose_matrix(r, A.in[14], 512, 1024, 1024, 0, 0, (bf16_t*)(ws + WS_WFO), nullptr, scr, lane)) continue;
            if (transpose_matrix(r, A.in[15], 1024, 1024, 1024, 0, 0, (bf16_t*)(ws + WS_WMO), nullptr, scr, lane)) continue;
            if (transpose_matrix(r, A.in[18], 1024, 512, 512, 0, 0, (bf16_t*)(ws + WS_WMQ), A.in[16], scr, lane)) continue;
            if (transpose_matrix(r, A.in[19], 1024, 1024, 1024, 0, 0, (bf16_t*)(ws + WS_WMKV), A.in[17], scr, lane)) continue;
            if (transpose_matrix(r, A.in[20], 512, 1024, 1024, 0, 0, (bf16_t*)(ws + WS_WMOO), nullptr, scr, lane)) continue;
            if (transpose_matrix(r, A.in[22], 1024, 5632, 5632, 2, 2816, (bf16_t*)(ws + WS_WF1), A.in[21], scr, lane)) continue;
            transpose_matrix(r, A.in[23], 2816, 1024, 1024, 0, 0, (bf16_t*)(ws + WS_WF2), nullptr, scr, lane);
        }
    }
    {
        bf16_t* U = (bf16_t*)(ws + WS_U); float* LF = (float*)(ws + WS_LF);
        for (int mm = gw; mm < M * REP_PROX; mm += ngw) { const int m = mm % M;
            const f32x4* xr = (const f32x4*)(x + (size_t)m * DM) + lane;
            f32x4 v[4]; float s = 0.f;
#pragma unroll
            for (int j = 0; j < 4; ++j) { v[j] = xr[64 * j]; s += (v[j][0] * v[j][0] + v[j][1] * v[j][1]) + (v[j][2] * v[j][2] + v[j][3] * v[j][3]); }
            const float rstd = 1.0f / sqrtf(wave_sum(s) * (1.0f / DM) + RMS_EPS);
            float f[8];
#pragma unroll
            for (int h = 0; h < 8; ++h) f[h] = 0.f;
#pragma unroll
            for (int j = 0; j < 4; ++j)
#pragma unroll
                for (int i = 0; i < 4; ++i) { const int k = 256 * j + 4 * lane + i; const f32x4 wa = *(LAS const f32x4*)(wf + k * 8), wb = *(LAS const f32x4*)(wf + k * 8 + 4); const float xv = v[j][i];
                    f[0] += xv * wa[0]; f[1] += xv * wa[1]; f[2] += xv * wa[2]; f[3] += xv * wa[3]; f[4] += xv * wb[0]; f[5] += xv * wb[1]; f[6] += xv * wb[2]; f[7] += xv * wb[3]; }
            float mine = 0.f;
#pragma unroll
            for (int h = 0; h < 8; ++h) { const float t = wave_sum(f[h]); if (lane == h) mine = t; }
            if (lane < 8) { const int b = m >> 13, t = m & 8191; LF[(size_t)(b * 8 + lane) * SEQ + t] = log_sigmoid(mine * rstd + b_forget[lane]); }
            u32x2* o8 = (u32x2*)(U + (size_t)m * DM) + lane;
#pragma unroll
            for (int j = 0; j < 4; ++j) { u32x2 w; w.x = pk2(v[j][0] * rstd, v[j][1] * rstd); w.y = pk2(v[j][2] * rstd, v[j][3] * rstd); o8[64 * j] = w; }
        }
    }
    {
        bf16_t* MN = (bf16_t*)(ws + WS_MN);
        for (int m = gw; m < BATCH * 256; m += ngw) {
            const f32x4* xr = (const f32x4*)(mem + (size_t)m * DM) + lane;
            f32x4 v[4]; float s = 0.f;
#pragma unroll
            for (int j = 0; j < 4; ++j) { v[j] = xr[64 * j]; s += (v[j][0] * v[j][0] + v[j][1] * v[j][1]) + (v[j][2] * v[j][2] + v[j][3] * v[j][3]); }
            const float rstd = 1.0f / sqrtf(wave_sum(s) * (1.0f / DM) + RMS_EPS);
            u32x2* o8 = (u32x2*)(MN + (size_t)m * DM) + lane;
#pragma unroll
            for (int j = 0; j < 4; ++j) { u32x2 w; w.x = pk2(v[j][0] * rstd, v[j][1] * rstd); w.y = pk2(v[j][2] * rstd, v[j][3] * rstd); o8[64 * j] = w; }
        }
    }
    if (gw < NG) {
        const int g = gw, p = lane, gp = g * 64 + p;
        const float* lam_re = A.in[5]; const float* lam_im = A.in[6]; const float* log_dt = A.in[7];
        const float* b_re = A.in[8]; const float* b_im = A.in[9]; const float* c_re = A.in[10]; const float* c_im = A.in[11];
        const float lr = lam_re[gp], li = lam_im[gp], dt = expf(log_dt[g]);
        const float mag = expf(lr * dt); float sn, cs; sincosf(li * dt, &sn, &cs);
        const float ar = mag * cs, ai = mag * sn;
        ((float2*)(ws + WS_LAMB))[gp] = make_float2(ar, ai);
        float pr = ar, pi = ai;
#pragma unroll
        for (int q = 0; q < 6; ++q) { const float nr = pr * pr - pi * pi, ni = 2.f * pr * pi; pr = nr; pi = ni; }
        ((float2*)(ws + WS_L64))[gp] = make_float2(pr, pi);
        const float den = lr * lr + li * li, nr_ = ar - 1.0f;
        const float cr = (nr_ * lr + ai * li) / den, ci = (ai * lr - nr_ * li) / den;
        float* bb = (float*)(ws + WS_BBAR) + (size_t)gp * 32;
#pragma unroll
        for (int n = 0; n < 16; ++n) { const float br = b_re[(size_t)gp * 16 + n], bi = b_im[(size_t)gp * 16 + n]; bb[n] = cr * br - ci * bi; bb[16 + n] = cr * bi + ci * br; }
        bf16_t* cmat = (bf16_t*)(ws + WS_CM);
#pragma unroll
        for (int n = 0; n < 16; ++n) { const size_t ci_ = (size_t)(g * 16 + n) * 64 + p;
            *(unsigned*)(cmat + (size_t)(g * 16 + n) * 128 + 2 * p) = pk2(c_re[ci_], -c_im[ci_]); }
    }
}

__device__ __forceinline__ void cumsum_seq(const float* lf, float* cum, int lane) {
    const float* p = lf + 128 * lane; double s = 0.0;
    for (int i = 0; i < 128; ++i) s += (double)p[i];
    double incl = s;
#pragma unroll
    for (int o = 1; o < 64; o <<= 1) { const double t = __shfl_up(incl, o); if (lane >= o) incl += t; }
    double run = incl - s;
    float* q = cum + 128 * lane;
    for (int i = 0; i < 128; ++i) { run += (double)p[i]; q[i] = (float)run; }
}

#define GAS __attribute__((address_space(1)))
#define RLX_AGENT __ATOMIC_RELAXED, __HIP_MEMORY_SCOPE_AGENT
#define XB_TMO      128
#define XB_XCNT(j)  (256  + 64 * (j))
#define XB_XSUB(j)  (1280 + 64 * (j))
#define XB_XGEN(j)  (2304 + 64 * (j))
#define XB_TOP      3328
#define XB_TOPGEN   3392
#define XCD_BAR_WORDS 3456
#define XB_SPIN_CAP (1u << 18)

__device__ __forceinline__ unsigned xb_ld(unsigned* p)              { return __hip_atomic_load(p, __ATOMIC_RELAXED, __HIP_MEMORY_SCOPE_AGENT); }
__device__ __forceinline__ unsigned xb_add(unsigned* p, unsigned v) { return __hip_atomic_fetch_add(p, v, __ATOMIC_RELAXED, __HIP_MEMORY_SCOPE_AGENT); }
__device__ __forceinline__ unsigned xb_xcc_id() { return (unsigned)__builtin_amdgcn_s_getreg((3 << 11) | 20) & 0xFu; }
#define XB_SPIN(cond, bar) do { unsigned _sp = 0; while (cond) { __builtin_amdgcn_s_sleep(1); \
    if ((++_sp & 255u) == 0u) { if (xb_ld(&(bar)[XB_TMO])) break; if (_sp > XB_SPIN_CAP) { atomicAdd(&(bar)[XB_TMO], 1u); break; } } } } while (0)

struct XcdBarrier {
    unsigned* bar; unsigned x;
    volatile LAS unsigned* st;
};

__device__ __forceinline__ XcdBarrier xcd_barrier_post(unsigned* bar, volatile LAS unsigned* st) {
    XcdBarrier b; b.bar = bar; b.x = xb_xcc_id(); b.st = st;
    if (threadIdx.x == 0) (void)xb_add(&bar[XB_XCNT(b.x)], 1u);
    return b;
}
__device__ __forceinline__ void xcd_barrier_complete(unsigned* bar, unsigned x, unsigned& nloc, unsigned& nx) {
    const unsigned G = gridDim.x * gridDim.y * gridDim.z;
    unsigned sum, cnt, mine, sp = 0u;
    for (;;) {
        sum = 0u; cnt = 0u; mine = 0u;
#pragma unroll
        for (unsigned j = 0; j < 16; ++j) { const unsigned c = xb_ld(&bar[XB_XCNT(j)]); sum += c; cnt += (c > 0u) ? 1u : 0u; mine = (j == x) ? c : mine; }
        if (sum == G) break;
        __builtin_amdgcn_s_sleep(1);
        if ((++sp & 255u) == 0u) { if (xb_ld(&bar[XB_TMO])) break; if (sp > XB_SPIN_CAP) { atomicAdd(&bar[XB_TMO], 1u); break; } }
    }
    nloc = mine > 0u ? mine : 1u; nx = cnt > 0u ? cnt : 1u;
}

__device__ __forceinline__ void xcd_barrier(const XcdBarrier& b) {
    asm volatile("s_waitcnt vmcnt(0)" ::: "memory");
    __syncthreads();
    if (threadIdx.x == 0) {
        unsigned* bar = b.bar;
        __builtin_amdgcn_s_waitcnt(0);
        unsigned nloc = b.st[0], nx = b.st[1];
        if (nloc == 0u) { xcd_barrier_complete(bar, b.x, nloc, nx); b.st[0] = nloc; b.st[1] = nx; }
        const unsigned old = xb_add(&bar[XB_XSUB(b.x)], 1u);
        const unsigned gen = old / nloc;
        if (old + 1u == (gen + 1u) * nloc) {
            __builtin_amdgcn_fence(__ATOMIC_RELEASE, "agent");
            asm volatile("s_waitcnt vmcnt(0)" ::: "memory");
            const unsigned og = xb_add(&bar[XB_TOP], 1u);
            const unsigned tg = og / nx;
            if (og + 1u == (tg + 1u) * nx) xb_add(&bar[XB_TOPGEN], 1u);
            else XB_SPIN(xb_ld(&bar[XB_TOPGEN]) == tg, bar);
            __builtin_amdgcn_fence(__ATOMIC_ACQUIRE, "agent");
            xb_add(&bar[XB_XGEN(b.x)], 1u);
            asm volatile("s_waitcnt vmcnt(0)" ::: "memory");
        } else {
            XB_SPIN(xb_ld(&bar[XB_XGEN(b.x)]) == gen, bar);
            __builtin_amdgcn_fence(__ATOMIC_ACQUIRE, "agent");
            asm volatile("s_waitcnt vmcnt(0)" ::: "memory");
        }
    }
    __syncthreads();
}

__global__ void __launch_bounds__(NTHR, 2) fwd_kernel(Args args) {
    extern __shared__ __attribute__((aligned(16))) unsigned char lds_raw[];
    LAS unsigned char* lds = (LAS unsigned char*)lds_raw;
    cg::grid_group grid = cg::this_grid();
    const int tid = threadIdx.x, lane = tid & 63, wid = __builtin_amdgcn_readfirstlane(tid >> 6);
    const int G = gridDim.x, bx = blockIdx.x;
    const int vcu = (G % 8 == 0) ? (bx % 8) * (G / 8) + bx / 8 : bx;
    const int gw = vcu * NWAVES + wid, ngw = G * NWAVES;
    unsigned char* ws = args.ws;
    const int lo = args.ph_lo, hi = args.ph_hi;
#define IN(k) (lo <= (k) && (k) < hi)
    volatile LAS unsigned* bst = (volatile LAS unsigned*)(lds + 131072 + 512);
    if (tid < 2) bst[tid] = 0u;
    __syncthreads();
    const bool multi = (hi - lo) > 1;
    XcdBarrier xbar; xbar.bar = (unsigned*)(ws + WS_BAR); xbar.x = 0; xbar.st = bst;
    if (multi) xbar = xcd_barrier_post((unsigned*)(ws + WS_BAR), bst);
    if (lo < 0) grid.sync();
#define SEAM(k) do { if (IN(k) && IN((k) + 1)) { for (int rep_ = 0; rep_ < REP_SYNC; ++rep_) xcd_barrier(xbar); } } while (0)
    bf16_t* PROJ = (bf16_t*)(ws + WS_PROJ); bf16_t* MIX = (bf16_t*)(ws + WS_U); bf16_t* HB = (bf16_t*)(ws + WS_HB);

    if (IN(0)) { prologue(args, lds, gw, ngw, lane, wid); }
    SEAM(0);
    if (IN(1)) {
        if (bx < 16 && wid == 0) cumsum_seq((const float*)(ws + WS_LF) + (size_t)bx * SEQ, (float*)(ws + WS_CUM) + (size_t)bx * SEQ, lane);
        pg8::Gemm g{(const bf16_t*)(ws + WS_U), (const bf16_t*)(ws + WS_WIN), M, 4096, 1024}; pg8::StaticOrder S; S.init(M, 4096, G, bx);
        pg8::EpiProj E{PROJ, 0.125f * LOG2E};
        for (int rep = 0; rep < REP_G1; ++rep) pg8::gemm_phase<pg8::EpiProj, pg8::StaticOrder, true, true>(lds, g, S, E);
    }
    SEAM(1);
    if (IN(2)) {
        for (int rep = 0; rep < REP_SSM1; ++rep) ssm_pass1(ws, gw, ngw, lane);
        const int bh = vcu >> 4, s = vcu & 15;
        if (bh < 16) {
            const int b = bh >> 3, h = bh & 7;
#pragma unroll 1
            for (int i = 0; i < 2 * REP_ATT; ++i) { const int qb = (i & 1) == 0 ? 31 - s : s;
                const size_t qrow = (size_t)b * SEQ + 256 * qb;
                attn_unit<64, true>(lds, PROJ + qrow * 4096 + 512 + 64 * h, PROJ + (size_t)b * SEQ * 4096 + 1024 + 64 * h, PROJ + (size_t)b * SEQ * 4096 + 1536 + 64 * h,
                                    (bf16_t*)(ws + WS_ATT) + qrow * 512 + 64 * h, 4096, 4096, 512, 4 * qb + 4, (const float*)(ws + WS_CUM) + (size_t)bh * SEQ, 256 * qb); }
        }
    }
    SEAM(2);
    if (IN(3)) { for (int rep = 0; rep < REP_SSM2; ++rep) ssm_pass2(ws, ws, args.in[12], lds, gw, ngw, lane, wid); }
    SEAM(3);
    if (IN(4)) {
        pg8::Gemm g{(const bf16_t*)(ws + WS_YSSM), (const bf16_t*)(ws + WS_WGLU), M, 2048, 512}; pg8::StaticOrder S; S.init(M, 2048, G, bx);
        pg8::EpiGlu E{PROJ, MIX};
        pg8::gemm_phase<pg8::EpiGlu, pg8::StaticOrder, true, true>(lds, g, S, E);
    }
    SEAM(4);
    if (IN(5)) {
        pg8::Gemm g{(const bf16_t*)(ws + WS_ATT), (const bf16_t*)(ws + WS_WFO), M, 1024, 512}; pg8::StaticOrder S; S.init(M, 1024, G, bx);
        pg8::EpiFoxO E{PROJ, MIX};
        pg8::gemm_phase<pg8::EpiFoxO, pg8::StaticOrder, true, true>(lds, g, S, E);
    }
    SEAM(5);
    if (IN(6)) {
        pg8::Gemm g{MIX, (const bf16_t*)(ws + WS_WMO), M, 1024, 1024}; pg8::StaticOrder S; S.init(M, 1024, G, bx);
        pg8::EpiRes E{args.in[0], args.out, HB, (float*)(ws + WS_SSQ1)};
        pg8::gemm_phase<pg8::EpiRes, pg8::StaticOrder, true, true>(lds, g, S, E);
    }
    SEAM(6);
    if (IN(7)) {
        if (bx < 128) {
            pg8::Gemm g{HB, (const bf16_t*)(ws + WS_WMQ), M, 512, 1024}; pg8::StaticOrder S; S.init(M, 512, G, bx);
            pg8::EpiPlain E{(bf16_t*)(ws + WS_QM), 512, (const float*)(ws + WS_SSQ1), 0.08838834764831845f * LOG2E};
            pg8::gemm_phase<pg8::EpiPlain, pg8::StaticOrder, true, true>(lds, g, S, E);
        } else {
            pg8::Gemm g{(const bf16_t*)(ws + WS_MN), (const bf16_t*)(ws + WS_WMKV), 512, 1024, 1024}; pg8::StaticOrder S; S.init(512, 1024, G, bx - 128);
            pg8::EpiPlain E{(bf16_t*)(ws + WS_KVM), 1024, nullptr, 1.0f};
            pg8::gemm_phase<pg8::EpiPlain, pg8::StaticOrder, true, true>(lds, g, S, E);
        }
    }
    SEAM(7);
    if (IN(8)) {
        for (int rep = 0; rep < REP_MATT; ++rep) for (int un = vcu; un < 256; un += G) { const int qb = un & 31, hm = (un >> 5) & 3, b = un >> 7;
            const size_t qrow = (size_t)b * SEQ + 256 * qb; const bf16_t* kv = (const bf16_t*)(ws + WS_KVM) + (size_t)b * 256 * 1024;
            attn_unit<128, false>(lds, (const bf16_t*)(ws + WS_QM) + qrow * 512 + 128 * hm, kv + 128 * hm, kv + 512 + 128 * hm,
                                  (bf16_t*)(ws + WS_OM) + qrow * 512 + 128 * hm, 512, 1024, 512, 4, nullptr, 0); }
    }
    SEAM(8);
    if (IN(9)) {
        pg8::Gemm g{(const bf16_t*)(ws + WS_OM), (const bf16_t*)(ws + WS_WMOO), M, 1024, 512}; pg8::StaticOrder S; S.init(M, 1024, G, bx);
        pg8::EpiRes E{args.out, args.out, HB, (float*)(ws + WS_SSQ2)};
        pg8::gemm_phase<pg8::EpiRes, pg8::StaticOrder, true, true>(lds, g, S, E);
    }
    SEAM(9);
    if (IN(10)) {
        pg8::Gemm g{HB, (const bf16_t*)(ws + WS_WF1), M, 2 * FFH, 1024}; pg8::StaticOrder S; S.init(M, 2 * FFH, G, bx);
        pg8::EpiFfn E{(const float*)(ws + WS_SSQ2), (bf16_t*)(ws + WS_HID)};
        for (int rep = 0; rep < REP_G7; ++rep) pg8::gemm_phase<pg8::EpiFfn, pg8::StaticOrder, true, true>(lds, g, S, E);
    }
    SEAM(10);
    if (IN(11)) {
        pg8::Gemm g{(const bf16_t*)(ws + WS_HID), (const bf16_t*)(ws + WS_WF2), M, 1024, FFH}; pg8::StaticOrder S; S.init(M, 1024, G, bx);
        pg8::EpiRes E{args.out, args.out, nullptr, (float*)(ws + WS_SSQ3)};
        pg8::gemm_phase<pg8::EpiRes, pg8::StaticOrder, true, true>(lds, g, S, E);
    }
    SEAM(11);
    if (IN(12)) {
        const float* gn = args.in[24]; const float* ssq = (const float*)(ws + WS_SSQ3);
        for (int m = gw; m < M; m += ngw) {
            const float rs = pg8::row_rstd(ssq, m);
            f32x4* xr = (f32x4*)(args.out + (size_t)m * DM) + lane; const f32x4* gr = (const f32x4*)gn + lane;
#pragma unroll
            for (int j = 0; j < 4; ++j) { const f32x4 v = xr[64 * j] * rs * gr[64 * j]; xr[64 * j] = v; }
        }
    }
#undef IN
#undef SEAM
}

constexpr int NPHASE = 13;
extern "C" void kernel_launch(void* const* d_in, const int* in_sizes, int n_in, void* d_out, int out_size, void* d_ws, size_t ws_size, hipStream_t stream) {
    static int grid = 0;
    if (grid == 0) {
        if (n_in != 25 || out_size != M * DM || ws_size < WS_END) { fprintf(stderr, "kernel_launch: unexpected shapes (n_in %d out %d ws %zu)\n", n_in, out_size, ws_size); grid = -1; return; }
        int dev = 0, cus = 0, per_cu = 0;
        (void)hipGetDevice(&dev); (void)hipDeviceGetAttribute(&cus, hipDeviceAttributeMultiprocessorCount, dev);
        if (hipFuncSetAttribute((const void*)fwd_kernel, hipFuncAttributeMaxDynamicSharedMemorySize, LDS_BYTES) != hipSuccess) { fprintf(stderr, "kernel_launch: hipFuncSetAttribute failed\n"); grid = -1; return; }
        if (hipOccupancyMaxActiveBlocksPerMultiprocessor(&per_cu, (const void*)fwd_kernel, NTHR, LDS_BYTES) != hipSuccess || per_cu < 1) fprintf(stderr, "kernel_launch: occupancy query says %d\n", per_cu);
        (void)hipGetLastError();
        grid = cus > 0 ? cus : 256;
    }
    if (grid < 0) return;
    Args a{};
    for (int i = 0; i < 25; ++i) a.in[i] = (const float*)d_in[i];
    a.out = (float*)d_out; a.ws = (unsigned char*)d_ws;
#if MK_ONE_LAUNCH
    a.ph_lo = 0; a.ph_hi = NPHASE;
    (void)hipMemsetAsync((unsigned char*)d_ws + WS_BAR, 0, BAR_BYTES, stream);
    void* kargs[] = {&a};
    hipError_t e = hipLaunchCooperativeKernel((const void*)fwd_kernel, dim3(grid), dim3(NTHR), kargs, LDS_BYTES, stream);
    if (e != hipSuccess) fprintf(stderr, "cooperative launch failed: %s (grid %d)\n", hipGetErrorString(e), grid);
#else
    for (int ph = 0; ph < NPHASE; ++ph) { a.ph_lo = ph; a.ph_hi = ph + 1; hipLaunchKernelGGL(fwd_kernel, dim3(grid), dim3(NTHR), LDS_BYTES, stream, a); }
#endif
}
```

```cpp
#include <hip/hip_runtime.h>
#include <hip/hip_cooperative_groups.h>
#include <cstdio>
#include <cstdint>
#include <cmath>
namespace cg = cooperative_groups;

#ifndef MK_ONE_LAUNCH
#define MK_ONE_LAUNCH 1
#endif
#ifndef REP_ATT
#define REP_ATT 1
#endif
#ifndef REP_SSM1
#define REP_SSM1 1
#endif
#ifndef REP_SSM2
#define REP_SSM2 1
#endif
#ifndef REP_PRO
#define REP_PRO 1
#endif
#ifndef REP_PROW
#define REP_PROW 1
#endif
#ifndef REP_PROX
#define REP_PROX 1
#endif
#ifndef REP_G1
#define REP_G1 1
#endif
#ifndef REP_G7
#define REP_G7 1
#endif
#ifndef REP_MATT
#define REP_MATT 1
#endif
#ifndef REP_SYNC
#define REP_SYNC 1
#endif
#undef MK_ONE_LAUNCH
#define MK_ONE_LAUNCH 1
namespace pg8 {
#define PG8_LAS __attribute__((address_space(3)))
typedef unsigned short bf16_t;
typedef short bf16x8 __attribute__((ext_vector_type(8)));
typedef float f32x4 __attribute__((ext_vector_type(4)));
typedef unsigned u32x4 __attribute__((ext_vector_type(4)));
constexpr int BM = 256, BK = 64, HALF = 128, HTB = HALF * BK * 2  , STAGE_BYTES = 8 * HTB, NXCD = 8, WGM = 8;

__host__ __device__ __forceinline__ int lds_byte(int r, int c) { const int st = (r >> 4) * 2 + (c >> 5), rr = r & 15, cc = c & 31, ob = rr * 64 + cc * 2; return st * 1024 + (ob ^ (((ob >> 9) & 1) << 5)); }
__host__ __device__ __forceinline__ void stage_rc(int b, int& R, int& C) { const int st = b / 1024, sb = b % 1024, swz = sb ^ (((sb >> 9) & 1) << 5); R = (st >> 1) * 16 + swz / 64; C = (st & 1) * 32 + (swz % 64) / 2; }
__host__ __device__ __forceinline__ int perm32(int rho) { const int n = rho >> 4, i = rho & 15; return 8 * (i >> 2) + 4 * n + (i & 3); }

struct Unit { int pm, pn; };
struct Gemm { const bf16_t* A; const bf16_t* Bt; int M, N, K; };

struct StaticOrder {
    int nM, nN, nwg, G, c;
    __host__ __device__ void init(int M, int N, int G_, int c_) { nM = M / BM; nN = N / BM; nwg = nM * nN; G = G_; c = c_; }
    __host__ __device__ bool next(int i, Unit& u) const {
        const long L = (long)i * G + c; if (L >= nwg) return false;
        int wgid = (int)L; { const int q = nwg / NXCD, r = nwg % NXCD, xcd = wgid % NXCD, off = wgid / NXCD; wgid = (xcd < r ? xcd * (q + 1) : r * (q + 1) + (xcd - r) * q) + off; }
        const int nig = WGM * nN, gid = wgid / nig, fm = gid * WGM, gsz = (nM - fm) < WGM ? (nM - fm) : WGM;
        u.pm = fm + ((wgid % nig) % gsz); u.pn = (wgid % nig) / gsz; return true;
    }
    __device__ __forceinline__ void a_ready(const Unit&) const {}
    __device__ __forceinline__ void done(const Unit&) const {}
};

__device__ __forceinline__ unsigned cvt_pk_bf16(float lo, float hi) { unsigned r; asm volatile("v_cvt_pk_bf16_f32 %0, %1, %2" : "=v"(r) : "v"(lo), "v"(hi)); return r; }
typedef float f32x2 __attribute__((ext_vector_type(2)));
template <class Epi, class Sched, bool ALIGN_EPI = false, bool SP2 = false>
__device__ __forceinline__ void gemm_phase(PG8_LAS unsigned char* lds, const Gemm g, const Sched& S, const Epi& E) {
    const int tid = threadIdx.x, wid = __builtin_amdgcn_readfirstlane(tid >> 6), lane = tid & 63, wr = wid >> 2, wc = wid & 3, fr = lane & 15, fq = lane >> 4;
    const int K = g.K, nt = K / BK;
    unsigned voffA[2], voffB[2];
#pragma unroll
    for (int i = 0; i < 2; ++i) { int R, C; stage_rc(tid * 16 + i * 8192, R, C); const int Rb = Epi::PERM ? ((R & ~31) + perm32(R & 31)) : R;
        voffA[i] = (unsigned)(R * K + C) * 2u; voffB[i] = (unsigned)(Rb * K + C) * 2u; }
    const size_t kstep = (size_t)(BK * 2);
    const size_t hstep = (size_t)HALF * K * 2;
    const size_t tstep = 2 * hstep;
    const unsigned ldsw = (unsigned)wid * 1024u;
    const int aoff = lds_byte(wr * 64 + fr, fq * 8), boff = lds_byte(wc * 32 + fr, fq * 8);
#define PG8_SA(b, h) (((b) * 2 + (h)) * HTB)
#define PG8_SB(b, h) ((4 + (b) * 2 + (h)) * HTB)
#define PG8_STAGE(bufoff, gbase, voff) do { _Pragma("unroll") for (int _i = 0; _i < 2; ++_i) \
        __builtin_amdgcn_global_load_lds((const unsigned*)((const char*)(gbase) + (voff)[_i]), (PG8_LAS unsigned*)(lds + (bufoff) + ldsw + _i * 8192), 16, 0, 0); } while (0)
#define PG8_LDA(dst, b, h) do { _Pragma("unroll") for (int m = 0; m < 4; ++m) _Pragma("unroll") for (int k = 0; k < 2; ++k) dst[m][k] = *(const PG8_LAS bf16x8*)(lds + PG8_SA(b, h) + aoff + m * 2048 + k * 1024); } while (0)
#define PG8_LDB(dst, b, h) do { _Pragma("unroll") for (int n = 0; n < 2; ++n) _Pragma("unroll") for (int k = 0; k < 2; ++k) dst[n][k] = *(const PG8_LAS bf16x8*)(lds + PG8_SB(b, h) + boff + n * 2048 + k * 1024); } while (0)
#define PG8_MMA(ai, bj, At, Bt) do { __builtin_amdgcn_s_setprio(1); _Pragma("unroll") for (int m = 0; m < 4; ++m) _Pragma("unroll") for (int n = 0; n < 2; ++n) _Pragma("unroll") for (int k = 0; k < 2; ++k) \
        acc[ai][bj][m][n] = __builtin_amdgcn_mfma_f32_16x16x32_bf16(Bt[n][k], At[m][k], acc[ai][bj][m][n], 0, 0, 0); __builtin_amdgcn_s_setprio(0); } while (0)
#define PG8_WAIT_V(n) asm volatile("s_waitcnt vmcnt(" #n ")" ::: "memory")
#define PG8_WAIT_L(n) asm volatile("s_waitcnt lgkmcnt(" #n ")" ::: "memory")
#define PG8_BAR __builtin_amdgcn_s_barrier()
#define PG8_SCHED __builtin_amdgcn_sched_barrier(0)
    Unit cur, nxt; int ui = 0;
    if (!S.next(0, cur)) return;
    f32x4 acc[2][2][4][2];
#pragma unroll
    for (int a = 0; a < 2; ++a)
#pragma unroll
        for (int b = 0; b < 2; ++b)
#pragma unroll
            for (int m = 0; m < 4; ++m)
#pragma unroll
                for (int n = 0; n < 2; ++n) acc[a][b][m][n] = (f32x4){0.f, 0.f, 0.f, 0.f};
    bf16x8 At[4][2], B0[2][2], B1[2][2];
    const char* cA = (const char*)g.A + (size_t)cur.pm * tstep; const char* cB = (const char*)g.Bt + (size_t)cur.pn * tstep;
    S.a_ready(cur);
    if constexpr (SP2) {
        PG8_STAGE(PG8_SB(0, 0), cB, voffB); PG8_STAGE(PG8_SB(0, 1), cB + hstep, voffB); PG8_STAGE(PG8_SA(0, 0), cA, voffA); PG8_STAGE(PG8_SA(0, 1), cA + hstep, voffA);
        if (wr == 1) PG8_BAR;
        PG8_WAIT_V(2); PG8_BAR;
        PG8_STAGE(PG8_SB(1, 0), cB + kstep, voffB); PG8_STAGE(PG8_SA(1, 0), cA + kstep, voffA); PG8_STAGE(PG8_SB(1, 1), cB + hstep + kstep, voffB);
        PG8_WAIT_V(6); PG8_BAR;
    } else {
        PG8_STAGE(PG8_SB(0, 0), cB, voffB); PG8_STAGE(PG8_SA(0, 0), cA, voffA); PG8_STAGE(PG8_SB(0, 1), cB + hstep, voffB); PG8_STAGE(PG8_SA(0, 1), cA + hstep, voffA);
        if (wr == 1) PG8_BAR;
        PG8_WAIT_V(4); PG8_BAR;
        PG8_STAGE(PG8_SB(1, 0), cB + kstep, voffB); PG8_STAGE(PG8_SA(1, 0), cA + kstep, voffA); PG8_STAGE(PG8_SB(1, 1), cB + hstep + kstep, voffB);
        PG8_WAIT_V(6); PG8_BAR;
    }
    for (;;) {
        const bool has_next = S.next(ui + 1, nxt);
        const char* nA = has_next ? (const char*)g.A + (size_t)nxt.pm * tstep : cA; const char* nB = has_next ? (const char*)g.Bt + (size_t)nxt.pn * tstep : cB;
        for (int t = 0; t < nt; t += 2) {
            const bool last = (t == nt - 2);
            const char* a1 = cA + (size_t)(t + 1) * kstep;
            const char* a2 = last ? nA : cA + (size_t)(t + 2) * kstep; const char* b2 = last ? nB : cB + (size_t)(t + 2) * kstep;
            const char* a3 = a2 + kstep; const char* b3 = b2 + kstep;
            if (last && has_next) S.a_ready(nxt);
            if constexpr (SP2) {
            PG8_LDB(B0, 0, 0); PG8_LDB(B1, 0, 1); PG8_SCHED; PG8_LDA(At, 0, 0); PG8_STAGE(PG8_SA(1, 1), a1 + hstep, voffA);
            PG8_WAIT_V(8); PG8_WAIT_L(0); PG8_BAR; PG8_MMA(0, 0, At, B0); PG8_MMA(0, 1, At, B1); PG8_BAR; PG8_SCHED;
            PG8_LDA(At, 0, 1); PG8_STAGE(PG8_SB(0, 0), b2, voffB); PG8_STAGE(PG8_SB(0, 1), b2 + hstep, voffB); PG8_STAGE(PG8_SA(0, 0), a2, voffA);
            PG8_WAIT_V(8); PG8_WAIT_L(0); PG8_BAR; PG8_MMA(1, 0, At, B0); PG8_MMA(1, 1, At, B1); PG8_BAR; PG8_SCHED;
            PG8_LDB(B0, 1, 0); PG8_LDB(B1, 1, 1); PG8_SCHED; PG8_LDA(At, 1, 0); PG8_STAGE(PG8_SA(0, 1), a2 + hstep, voffA);
            PG8_WAIT_V(8); PG8_WAIT_L(0); PG8_BAR; PG8_MMA(0, 0, At, B0); PG8_MMA(0, 1, At, B1); PG8_BAR; PG8_SCHED;
            PG8_LDA(At, 1, 1); PG8_STAGE(PG8_SB(1, 0), b3, voffB); PG8_STAGE(PG8_SB(1, 1), b3 + hstep, voffB); PG8_STAGE(PG8_SA(1, 0), a3, voffA);
            PG8_WAIT_V(8); PG8_WAIT_L(0); PG8_BAR; PG8_MMA(1, 0, At, B0); PG8_MMA(1, 1, At, B1); PG8_BAR; PG8_SCHED;
            } else {
            PG8_LDB(B0, 0, 0); PG8_SCHED; PG8_LDA(At, 0, 0); PG8_STAGE(PG8_SA(1, 1), a1 + hstep, voffA);
            PG8_WAIT_L(8); PG8_BAR; PG8_WAIT_L(0); PG8_MMA(0, 0, At, B0); PG8_BAR; PG8_SCHED;
            PG8_LDB(B1, 0, 1); PG8_STAGE(PG8_SB(0, 0), b2, voffB);
            PG8_BAR; PG8_WAIT_L(0); PG8_MMA(0, 1, At, B1); PG8_BAR;
            PG8_LDA(At, 0, 1); PG8_STAGE(PG8_SA(0, 0), a2, voffA);
            PG8_BAR; PG8_WAIT_L(0); PG8_MMA(1, 0, At, B0); PG8_BAR; PG8_SCHED;
            PG8_STAGE(PG8_SB(0, 1), b2 + hstep, voffB);
            PG8_WAIT_V(6); PG8_BAR; PG8_MMA(1, 1, At, B1); PG8_BAR;
            PG8_LDB(B0, 1, 0); PG8_SCHED; PG8_LDA(At, 1, 0); PG8_STAGE(PG8_SA(0, 1), a2 + hstep, voffA);
            PG8_WAIT_L(8); PG8_BAR; PG8_WAIT_L(0); PG8_MMA(0, 0, At, B0); PG8_BAR; PG8_SCHED;
            PG8_LDB(B1, 1, 1); PG8_STAGE(PG8_SB(1, 0), b3, voffB);
            PG8_BAR; PG8_WAIT_L(0); PG8_MMA(0, 1, At, B1); PG8_BAR;
            PG8_LDA(At, 1, 1); PG8_STAGE(PG8_SA(1, 0), a3, voffA);
            PG8_BAR; PG8_WAIT_L(0); PG8_MMA(1, 0, At, B0); PG8_BAR; PG8_SCHED;
            PG8_STAGE(PG8_SB(1, 1), b3 + hstep, voffB);
            PG8_WAIT_V(6); PG8_BAR; PG8_MMA(1, 1, At, B1); PG8_BAR;
            }
        }
        if constexpr (ALIGN_EPI) { if (wr == 0) PG8_BAR; }
        if constexpr (!Epi::AFTER_DRAIN) { E(acc, cur, wr, wc, fr, fq); S.done(cur); }
        if (!has_next) break;
#pragma unroll
        for (int a = 0; a < 2; ++a)
#pragma unroll
            for (int b = 0; b < 2; ++b)
#pragma unroll
                for (int m = 0; m < 4; ++m)
#pragma unroll
                    for (int n = 0; n < 2; ++n) acc[a][b][m][n] = (f32x4){0.f, 0.f, 0.f, 0.f};
        cur = nxt; cA = nA; cB = nB; ++ui;
        if constexpr (ALIGN_EPI) { if (wr == 1) PG8_BAR; }
    }
    PG8_WAIT_V(0);
    if constexpr (!ALIGN_EPI) { if (wr == 0) PG8_BAR; }
    PG8_BAR;
    if constexpr (Epi::AFTER_DRAIN) { E.fused(acc, cur, wr, wc, fr, fq, lds, wid, lane); S.done(cur); }
#undef PG8_SA
#undef PG8_SB
#undef PG8_STAGE
#undef PG8_LDA
#undef PG8_LDB
#undef PG8_MMA
#undef PG8_WAIT_V
#undef PG8_WAIT_L
#undef PG8_BAR
#undef PG8_SCHED
}

typedef unsigned u32x2 __attribute__((ext_vector_type(2)));
__device__ __forceinline__ float sigm(float v) { return __builtin_amdgcn_rcpf(1.f + __expf(-v)); }
__device__ __forceinline__ float bf_lo(unsigned w) { return __uint_as_float(w << 16); }
__device__ __forceinline__ float bf_hi(unsigned w) { return __uint_as_float(w & 0xffff0000u); }
constexpr float RMS_EPS_ = 1e-6f;
__device__ __forceinline__ float row_rstd(const float* ssq, int row) {
    const f32x4* p = (const f32x4*)(ssq + (size_t)row * 16);
    const f32x4 a = p[0], b = p[1], c = p[2], d = p[3];
    const float s = ((a[0] + a[1]) + (a[2] + a[3])) + ((b[0] + b[1]) + (b[2] + b[3])) + ((c[0] + c[1]) + (c[2] + c[3])) + ((d[0] + d[1]) + (d[2] + d[3]));
    return 1.0f / sqrtf(s * (1.0f / 1024.0f) + RMS_EPS_);
}

struct EpiProj {
    static constexpr bool PERM = true, AFTER_DRAIN = false;
    bf16_t* O; float qscale; unsigned* km2;
    __device__ __forceinline__ void operator()(const f32x4 (&acc)[2][2][4][2], const Unit& u, int wr, int wc, int fr, int fq) const {
        const int row0 = u.pm * BM + wr * 64 + fr, colt = u.pn * BM, col0 = colt + wc * 32 + 8 * fq;
        const int mode = (colt >= 2048) ? 2 : ((colt >= 512 && colt < 1024) ? 1 : 0);
        if (colt >= 1024 && colt < 1536) {
#pragma unroll
            for (int bj = 0; bj < 2; ++bj) { float mx = 0.f;
#pragma unroll
                for (int ai = 0; ai < 2; ++ai)
#pragma unroll
                    for (int m = 0; m < 4; ++m) { const f32x4 v0 = acc[ai][bj][m][0], v1 = acc[ai][bj][m][1];
                        float ss = ((v0[0] * v0[0] + v0[1] * v0[1]) + (v0[2] * v0[2] + v0[3] * v0[3])) + ((v1[0] * v1[0] + v1[1] * v1[1]) + (v1[2] * v1[2] + v1[3] * v1[3]));
                        ss += __shfl_xor(ss, 16); ss += __shfl_xor(ss, 32); mx = fmaxf(mx, ss); }
                mx = fmaxf(mx, __shfl_xor(mx, 1)); mx = fmaxf(mx, __shfl_xor(mx, 2)); mx = fmaxf(mx, __shfl_xor(mx, 4)); mx = fmaxf(mx, __shfl_xor(mx, 8));
                const int colg = colt - 1024 + bj * HALF + wc * 32;
                if (fr == 0 && fq == 0) atomicMax(km2 + ((u.pm >= 32 ? 8 : 0) + (colg >> 6)) * 2 + ((colg >> 5) & 1), __float_as_uint(mx)); }
        }
#pragma unroll
        for (int ai = 0; ai < 2; ++ai)
#pragma unroll
            for (int m = 0; m < 4; ++m) { bf16_t* rowp = O + (size_t)(row0 + ai * HALF + m * 16) * 4096 + col0;
#pragma unroll
                for (int bj = 0; bj < 2; ++bj) { f32x4 v0 = acc[ai][bj][m][0], v1 = acc[ai][bj][m][1];
                    if (mode == 1) { v0 = v0 * qscale; v1 = v1 * qscale; }
                    if (mode == 2) { v0 = (f32x4){sigm(v0[0]), sigm(v0[1]), sigm(v0[2]), sigm(v0[3])}; v1 = (f32x4){sigm(v1[0]), sigm(v1[1]), sigm(v1[2]), sigm(v1[3])}; }
                    u32x4 w; w.x = cvt_pk_bf16(v0[0], v0[1]); w.y = cvt_pk_bf16(v0[2], v0[3]); w.z = cvt_pk_bf16(v1[0], v1[1]); w.w = cvt_pk_bf16(v1[2], v1[3]);
                    *(u32x4*)(rowp + bj * HALF) = w; } }
    }
};
struct EpiPlain {
    static constexpr bool PERM = true, AFTER_DRAIN = false;
    bf16_t* O; int ldc; const float* ssq; float scale;
    __device__ __forceinline__ void operator()(const f32x4 (&acc)[2][2][4][2], const Unit& u, int wr, int wc, int fr, int fq) const {
        const int row0 = u.pm * BM + wr * 64 + fr, col0 = u.pn * BM + wc * 32 + 8 * fq;
#pragma unroll
        for (int ai = 0; ai < 2; ++ai)
#pragma unroll
            for (int m = 0; m < 4; ++m) { const int row = row0 + ai * HALF + m * 16; bf16_t* rowp = O + (size_t)row * ldc + col0;
                const float sc = ssq ? row_rstd(ssq, row) * scale : scale;
#pragma unroll
                for (int bj = 0; bj < 2; ++bj) { const f32x4 v0 = acc[ai][bj][m][0] * sc, v1 = acc[ai][bj][m][1] * sc;
                    u32x4 w; w.x = cvt_pk_bf16(v0[0], v0[1]); w.y = cvt_pk_bf16(v0[2], v0[3]); w.z = cvt_pk_bf16(v1[0], v1[1]); w.w = cvt_pk_bf16(v1[2], v1[3]);
                    *(u32x4*)(rowp + bj * HALF) = w; } }
    }
};
struct EpiGlu {
    static constexpr bool PERM = false, AFTER_DRAIN = false;
    const bf16_t* proj; bf16_t* mix;
    __device__ __forceinline__ void operator()(const f32x4 (&acc)[2][2][4][2], const Unit& u, int wr, int wc, int fr, int fq) const {
#pragma unroll
        for (int ai = 0; ai < 2; ++ai)
#pragma unroll
            for (int m = 0; m < 4; ++m) { const int row = u.pm * BM + ai * HALF + wr * 64 + m * 16 + fr;
#pragma unroll
                for (int n = 0; n < 2; ++n) { const int ch0 = u.pn * HALF + wc * 32 + 16 * n + 4 * fq;
                    const u32x2 gw = *(const u32x2*)(proj + (size_t)row * 4096 + 2048 + ch0);
                    const f32x4 a = acc[ai][0][m][n], b = acc[ai][1][m][n];
                    const float o0 = bf_lo(gw.x) * a[0] * sigm(b[0]), o1 = bf_hi(gw.x) * a[1] * sigm(b[1]), o2 = bf_lo(gw.y) * a[2] * sigm(b[2]), o3 = bf_hi(gw.y) * a[3] * sigm(b[3]);
                    u32x2 w; w.x = cvt_pk_bf16(o0, o1); w.y = cvt_pk_bf16(o2, o3);
                    *(u32x2*)(mix + (size_t)row * 1024 + ch0) = w; } }
    }
};
struct EpiFoxO {
    static constexpr bool PERM = true, AFTER_DRAIN = false;
    const bf16_t* proj; bf16_t* mix;
    __device__ __forceinline__ void operator()(const f32x4 (&acc)[2][2][4][2], const Unit& u, int wr, int wc, int fr, int fq) const {
        const int row0 = u.pm * BM + wr * 64 + fr, col0 = u.pn * BM + wc * 32 + 8 * fq;
#pragma unroll
        for (int ai = 0; ai < 2; ++ai)
#pragma unroll
            for (int m = 0; m < 4; ++m) { const int row = row0 + ai * HALF + m * 16;
#pragma unroll
                for (int bj = 0; bj < 2; ++bj) { const int ch0 = col0 + bj * HALF;
                    const u32x4 gw = *(const u32x4*)(proj + (size_t)row * 4096 + 3072 + ch0);
                    bf16_t* mp = mix + (size_t)row * 1024 + ch0; const u32x4 mw = *(const u32x4*)mp;
                    const f32x4 v0 = acc[ai][bj][m][0], v1 = acc[ai][bj][m][1];
                    u32x4 w;
                    w.x = cvt_pk_bf16(bf_lo(mw.x) + bf_lo(gw.x) * v0[0], bf_hi(mw.x) + bf_hi(gw.x) * v0[1]);
                    w.y = cvt_pk_bf16(bf_lo(mw.y) + bf_lo(gw.y) * v0[2], bf_hi(mw.y) + bf_hi(gw.y) * v0[3]);
                    w.z = cvt_pk_bf16(bf_lo(mw.z) + bf_lo(gw.z) * v1[0], bf_hi(mw.z) + bf_hi(gw.z) * v1[1]);
                    w.w = cvt_pk_bf16(bf_lo(mw.w) + bf_lo(gw.w) * v1[2], bf_hi(mw.w) + bf_hi(gw.w) * v1[3]);
                    *(u32x4*)mp = w; } }
    }
};
struct EpiRes {
    static constexpr bool PERM = false, AFTER_DRAIN = false;
    const float* res; float* out; bf16_t* hb; float* ssq;
    __device__ __forceinline__ void operator()(const f32x4 (&acc)[2][2][4][2], const Unit& u, int wr, int wc, int fr, int fq) const {
#pragma unroll
        for (int ai = 0; ai < 2; ++ai)
#pragma unroll
            for (int m = 0; m < 4; ++m) { const int row = u.pm * BM + ai * HALF + wr * 64 + m * 16 + fr; float ss = 0.f;
#pragma unroll
                for (int bj = 0; bj < 2; ++bj)
#pragma unroll
                    for (int n = 0; n < 2; ++n) { const size_t off = (size_t)row * 1024 + u.pn * BM + bj * HALF + wc * 32 + 16 * n + 4 * fq;
                        const f32x4 h = *(const f32x4*)(res + off) + acc[ai][bj][m][n];
                        *(f32x4*)(out + off) = h; ss += (h[0] * h[0] + h[1] * h[1]) + (h[2] * h[2] + h[3] * h[3]);
                        if (hb) { u32x2 w; w.x = cvt_pk_bf16(h[0], h[1]); w.y = cvt_pk_bf16(h[2], h[3]); *(u32x2*)(hb + off) = w; } }
                ss += __shfl_xor(ss, 16); ss += __shfl_xor(ss, 32);
                if (fq == 0) ssq[(size_t)row * 16 + u.pn * 4 + wc] = ss; }
    }
};
struct EpiFfn {
    static constexpr bool PERM = false, AFTER_DRAIN = false;
    const float* ssq; bf16_t* hid;
    __device__ __forceinline__ void operator()(const f32x4 (&acc)[2][2][4][2], const Unit& u, int wr, int wc, int fr, int fq) const {
#pragma unroll
        for (int ai = 0; ai < 2; ++ai)
#pragma unroll
            for (int m = 0; m < 4; ++m) { const int row = u.pm * BM + ai * HALF + wr * 64 + m * 16 + fr; const float rs = row_rstd(ssq, row);
#pragma unroll
                for (int n = 0; n < 2; ++n) { const int ch0 = u.pn * HALF + wc * 32 + 16 * n + 4 * fq;
                    const f32x4 a = acc[ai][0][m][n] * rs, b = acc[ai][1][m][n] * rs;
                    u32x2 w; w.x = cvt_pk_bf16(a[0] * sigm(a[0]) * b[0], a[1] * sigm(a[1]) * b[1]); w.y = cvt_pk_bf16(a[2] * sigm(a[2]) * b[2], a[3] * sigm(a[3]) * b[3]);
                    *(u32x2*)(hid + (size_t)row * 2816 + ch0) = w; } }
    }
};
}

#define LAS __attribute__((address_space(3)))
typedef unsigned short bf16_t;
typedef short bf16x8 __attribute__((ext_vector_type(8)));
typedef short s16x4 __attribute__((ext_vector_type(4)));
typedef float f32x4 __attribute__((ext_vector_type(4)));
typedef float f32x16 __attribute__((ext_vector_type(16)));
typedef unsigned u32x4 __attribute__((ext_vector_type(4)));
typedef unsigned u32x2 __attribute__((ext_vector_type(2)));

constexpr int NWAVES = 8, NTHR = 512;
constexpr int BATCH = 2, SEQ = 8192, DM = 1024, M = BATCH * SEQ;
constexpr int NG = 32, NP = 64, NCHUNK = 128, LC = 64;
constexpr int FFH = 2816;
constexpr float LOG2E = 1.4426950408889634f;
constexpr float RMS_EPS = 1e-6f;
constexpr size_t MiB = 1u << 20;
constexpr size_t WS_LAMB = 0, WS_L64 = 16384, WS_BT = 65536, WS_CM = 65536 + 262144;
constexpr size_t WS_BAR = 491520, BAR_BYTES = 16384, WS_KM2 = WS_BAR + 15360, WS_QCNT = WS_BAR + 15360 + 256;
constexpr size_t WS_LF = 1 * MiB, WS_CUM = 1 * MiB + 512 * 1024;
constexpr size_t WS_E = 2 * MiB;
constexpr size_t WS_SSQ1 = 6 * MiB, WS_SSQ2 = 7 * MiB, WS_SSQ3 = 8 * MiB;
constexpr size_t WS_MN = 9 * MiB, WS_KVM = 10 * MiB;
constexpr size_t WS_WIN = 12 * MiB, WS_WGLU = 20 * MiB, WS_WFO = 22 * MiB, WS_WMO = 23 * MiB, WS_WMQ = 25 * MiB, WS_WMKV = 26 * MiB, WS_WMOO = 28 * MiB, WS_WF1 = 29 * MiB, WS_WF2 = 40 * MiB;
constexpr size_t WS_U = 48 * MiB;
constexpr size_t WS_PROJ = 80 * MiB;
constexpr size_t WS_HB = 80 * MiB, WS_QM = 112 * MiB, WS_OM = 128 * MiB, WS_HID = 112 * MiB;
constexpr size_t WS_ATT = 208 * MiB, WS_YSSM = 224 * MiB;
constexpr size_t WS_END = 240 * MiB;
constexpr int LDS_BYTES = 131072 + 1024;

__device__ __forceinline__ unsigned f2bf(float f) { unsigned u = __builtin_bit_cast(unsigned, f); return (u + 0x7fffu + ((u >> 16) & 1u)) >> 16; }
__device__ __forceinline__ unsigned pk2(float lo, float hi) { return f2bf(lo) | (f2bf(hi) << 16); }
__device__ __forceinline__ unsigned cvtpk(float lo, float hi) { unsigned r; asm volatile("v_cvt_pk_bf16_f32 %0, %1, %2" : "=v"(r) : "v"(lo), "v"(hi)); return r; }
__device__ __forceinline__ float bfl(unsigned w) { return __uint_as_float(w << 16); }
__device__ __forceinline__ float bfh(unsigned w) { return __uint_as_float(w & 0xffff0000u); }
__device__ __forceinline__ float wave_sum(float v) {
#pragma unroll
    for (int o = 1; o < 64; o <<= 1) v += __shfl_xor(v, o);
    return v;
}
__device__ __forceinline__ float swap_max(float m) { auto rr = __builtin_amdgcn_permlane32_swap(__float_as_uint(m), __float_as_uint(m), false, false); return fmaxf(__uint_as_float(rr[0]), __uint_as_float(rr[1])); }
__device__ __forceinline__ float swap_sum(float m) { auto rr = __builtin_amdgcn_permlane32_swap(__float_as_uint(m), __float_as_uint(m), false, false); return __uint_as_float(rr[0]) + __uint_as_float(rr[1]); }

struct Args {
    const float* in[25]; float* out; unsigned char* ws; int ph_lo, ph_hi;
};

__device__ __forceinline__ int crow(int r, int hi) { return (r & 3) + 8 * (r >> 2) + 4 * hi; }
typedef short v4i16_t __attribute__((ext_vector_type(4)));
__device__ __forceinline__ s16x4 vtr(LAS const unsigned char* p) { return __builtin_bit_cast(s16x4, __builtin_amdgcn_ds_read_tr16_b64_v4i16((LAS v4i16_t*)p)); }

template <int D, bool FOX>
__device__ __forceinline__ void attn_unit(LAS unsigned char* lds, const bf16_t* Q, const bf16_t* K, const bf16_t* V, bf16_t* O,
                                          int qpitch, int kvpitch, int opitch, int ntiles, const float* cum, int qpos0) {
    constexpr int TB = D * 128;
    constexpr int NPASS = D / 64;
    constexpr int OFF_K = 0, OFF_V = 2 * TB, OFF_CK = 4 * TB, OFF_WS = 4 * TB + 512;
    const int tid = threadIdx.x, lane = tid & 63, r32 = lane & 31, hi = lane >> 5;
    const int wid = __builtin_amdgcn_readfirstlane(tid >> 6);
    LAS float* wsf = (LAS float*)(lds + OFF_WS) + wid * 32;
    bf16x8 qr[D / 16];
    { const bf16_t* qrow = Q + (size_t)(32 * wid + r32) * qpitch + 8 * hi;
#pragma unroll
      for (int d0 = 0; d0 < D / 16; ++d0) qr[d0] = *(const bf16x8*)(qrow + 16 * d0); }
    const int qpos = qpos0 + 32 * wid + r32;
    float cq = 0.f, cref = 0.f;
    if (FOX) { cref = cum[qpos0 + 255]; cq = (cum[qpos] - cref) * LOG2E; }
    f32x16 o[D / 32];
#pragma unroll
    for (int i = 0; i < D / 32; ++i)
#pragma unroll
        for (int r = 0; r < 16; ++r) o[i][r] = 0.f;
    float mrun = cq, lrun = 0.f;
    bool first = true;
    f32x16 negm;
#pragma unroll
    for (int r = 0; r < 16; ++r) negm[r] = 0.f;
    u32x4 kreg[NPASS], vreg[NPASS]; float ckreg = 0.f;
#define ATT_LOAD(t) do { _Pragma("unroll") for (int ps = 0; ps < NPASS; ++ps) { const int id = ps * 512 + tid; \
        kreg[ps] = *(const u32x4*)(K + (size_t)(64 * (t) + (id & 63)) * kvpitch + 8 * (id >> 6)); \
        vreg[ps] = *(const u32x4*)(V + (size_t)(64 * (t) + ((id & 255) >> 2)) * kvpitch + 32 * (id >> 8) + 8 * (id & 3)); } \
        if (FOX && tid < 64) ckreg = (cum[64 * (t) + tid] - cref) * LOG2E; } while (0)
#define ATT_WRITE(slot) do { _Pragma("unroll") for (int ps = 0; ps < NPASS; ++ps) { const int id = ps * 512 + tid; \
        *(LAS u32x4*)(lds + OFF_K + (slot) * TB + id * 16) = kreg[ps]; *(LAS u32x4*)(lds + OFF_V + (slot) * TB + id * 16) = vreg[ps]; } \
        if (FOX && tid < 64) *(LAS float*)(lds + OFF_CK + (slot) * 256 + tid * 4) = ckreg; } while (0)
    int cur = 0;
    ATT_LOAD(ntiles - 1); ATT_WRITE(0); __syncthreads();
    const int vbase = (4 * hi + ((lane & 15) >> 2)) * 64 + ((lane >> 4) & 1) * 32 + (lane & 3) * 8;
    for (int t = ntiles - 1; t >= 0; --t) {
        if (t > 0) ATT_LOAD(t - 1);
        const bool active = !FOX || (64 * t <= qpos0 + 32 * wid + 31);
        if (active) {
            LAS const unsigned char* Ks = lds + OFF_K + cur * TB; LAS const unsigned char* Vs = lds + OFF_V + cur * TB;
            f32x16 p0 = negm, p1 = negm;
#pragma unroll
            for (int d0 = 0; d0 < D / 16; ++d0) {
                const bf16x8 k0 = *(LAS const bf16x8*)(Ks + (2 * d0 + hi) * 1024 + r32 * 16);
                const bf16x8 k1 = *(LAS const bf16x8*)(Ks + (2 * d0 + hi) * 1024 + 512 + r32 * 16);
                p0 = __builtin_amdgcn_mfma_f32_32x32x16_bf16(k0, qr[d0], p0, 0, 0, 0);
                p1 = __builtin_amdgcn_mfma_f32_32x32x16_bf16(k1, qr[d0], p1, 0, 0, 0);
            }
            if (FOX) {
                LAS const float* cks = (LAS const float*)(lds + OFF_CK + cur * 256);
#pragma unroll
                for (int g4 = 0; g4 < 4; ++g4) {
                    const f32x4 c0 = *(LAS const f32x4*)(cks + 8 * g4 + 4 * hi), c1 = *(LAS const f32x4*)(cks + 32 + 8 * g4 + 4 * hi);
#pragma unroll
                    for (int i = 0; i < 4; ++i) { p0[4 * g4 + i] -= c0[i]; p1[4 * g4 + i] -= c1[i]; }
                }
                if (64 * t + 63 > qpos0 + 32 * wid) {
#pragma unroll
                    for (int r = 0; r < 16; ++r) { const int kv = 64 * t + crow(r, hi); if (kv > qpos) p0[r] = -INFINITY; if (kv + 32 > qpos) p1[r] = -INFINITY; }
                }
            }
            float rm = fmaxf(p0[0], p1[0]);
#pragma unroll
            for (int r = 1; r < 16; ++r) rm = fmaxf(rm, fmaxf(p0[r], p1[r]));
            rm = swap_max(rm);
            if (first || __any(rm > 8.0f)) {
                const float dl = first ? rm : fmaxf(rm, 0.f), alpha = first ? 1.0f : __builtin_amdgcn_exp2f(-dl);
                mrun += dl; lrun *= alpha; first = false;
#pragma unroll
                for (int r = 0; r < 16; ++r) { p0[r] -= dl; p1[r] -= dl; negm[r] = cq - mrun; }
                if (hi == 0) wsf[r32] = alpha;
#pragma unroll
                for (int g4 = 0; g4 < 4; ++g4) { const f32x4 a4 = *(LAS const f32x4*)(wsf + 8 * g4 + 4 * hi);
#pragma unroll
                    for (int i = 0; i < 4; ++i)
#pragma unroll
                        for (int d0 = 0; d0 < D / 32; ++d0) o[d0][4 * g4 + i] *= a4[i]; }
            }
            float ls = 0.f;
#pragma unroll
            for (int r = 0; r < 16; ++r) { p0[r] = __builtin_amdgcn_exp2f(p0[r]); p1[r] = __builtin_amdgcn_exp2f(p1[r]); ls += p0[r] + p1[r]; }
            lrun += ls;
            bf16x8 pa[4];
            { u32x4 w;
              w.x = cvtpk(p0[0], p0[1]); w.y = cvtpk(p0[2], p0[3]); w.z = cvtpk(p0[4], p0[5]); w.w = cvtpk(p0[6], p0[7]); pa[0] = __builtin_bit_cast(bf16x8, w);
              w.x = cvtpk(p0[8], p0[9]); w.y = cvtpk(p0[10], p0[11]); w.z = cvtpk(p0[12], p0[13]); w.w = cvtpk(p0[14], p0[15]); pa[1] = __builtin_bit_cast(bf16x8, w);
              w.x = cvtpk(p1[0], p1[1]); w.y = cvtpk(p1[2], p1[3]); w.z = cvtpk(p1[4], p1[5]); w.w = cvtpk(p1[6], p1[7]); pa[2] = __builtin_bit_cast(bf16x8, w);
              w.x = cvtpk(p1[8], p1[9]); w.y = cvtpk(p1[10], p1[11]); w.z = cvtpk(p1[12], p1[13]); w.w = cvtpk(p1[14], p1[15]); pa[3] = __builtin_bit_cast(bf16x8, w); }
#pragma unroll
            for (int d0 = 0; d0 < D / 32; ++d0)
#pragma unroll
                for (int ks = 0; ks < 4; ++ks) {
                    const s16x4 lo = vtr(Vs + d0 * 4096 + ks * 1024 + vbase), hh = vtr(Vs + d0 * 4096 + ks * 1024 + 512 + vbase);
                    const bf16x8 vf = (bf16x8){lo[0], lo[1], lo[2], lo[3], hh[0], hh[1], hh[2], hh[3]};
                    o[d0] = __builtin_amdgcn_mfma_f32_32x32x16_bf16(pa[ks], vf, o[d0], 0, 0, 0);
                }
        }
        if (t > 0) ATT_WRITE(cur ^ 1);
        __syncthreads();
        cur ^= 1;
    }
#undef ATT_LOAD
#undef ATT_WRITE
    const float lt = swap_sum(lrun);
    if (hi == 0) wsf[r32] = 1.0f / lt;
#pragma unroll
    for (int g4 = 0; g4 < 4; ++g4) { const f32x4 a4 = *(LAS const f32x4*)(wsf + 8 * g4 + 4 * hi);
#pragma unroll
        for (int i = 0; i < 4; ++i) { const int r = 4 * g4 + i; bf16_t* orow = O + (size_t)(32 * wid + crow(r, hi)) * opitch + r32;
#pragma unroll
            for (int d0 = 0; d0 < D / 32; ++d0) orow[32 * d0] = (bf16_t)f2bf(o[d0][r] * a4[i]); } }
    __syncthreads();
}

__device__ __forceinline__ float bf2f(short s) { return __uint_as_float(((unsigned)(unsigned short)s) << 16); }
__device__ __forceinline__ void fox_unit(LAS unsigned char* lds, const bf16_t* PROJ, bf16_t* ATT, const float* CUMall, const unsigned* km2, int bh, int u) {
    constexpr int TB = 8192;
    constexpr int OFF_K = 0, OFF_V = 4 * TB, OFF_CK = 8 * TB, OFF_WS = OFF_CK + 1024, OFF_NEED = OFF_WS + 4096, OFF_CMB = OFF_NEED + 64;
    const int tid = threadIdx.x, lane = tid & 63, r32 = lane & 31, hi = lane >> 5;
    const int wid = __builtin_amdgcn_readfirstlane(tid >> 6), rg = wid & 3, kp = wid >> 2;
    const int b = bh >> 3, h = bh & 7, q0 = 128 * u;
    const size_t rowb = (size_t)b * SEQ;
    const float* cum = CUMall + (size_t)bh * SEQ;
    const bf16_t* K = PROJ + rowb * 4096 + 1024 + 64 * h; const bf16_t* V = PROJ + rowb * 4096 + 1536 + 64 * h;
    LAS float* wsf = (LAS float*)(lds + OFF_WS) + wid * 128;
    bf16x8 qr[4];
    { const bf16_t* qrow = PROJ + (rowb + q0 + 32 * rg + r32) * 4096 + 512 + 64 * h + 8 * hi;
#pragma unroll
      for (int d0 = 0; d0 < 4; ++d0) qr[d0] = *(const bf16x8*)(qrow + 16 * d0); }
    const int qpos0w = q0 + 32 * rg, qpos = qpos0w + r32;
    const float cref = cum[q0 + 127], cq = (cum[qpos] - cref) * LOG2E;
    float needc;
    { float qs = 0.f;
#pragma unroll
      for (int d0 = 0; d0 < 4; ++d0)
#pragma unroll
          for (int j = 0; j < 8; ++j) { const float v = bf2f(qr[d0][j]); qs += v * v; }
      qs = swap_sum(qs);
      const float kmax = sqrtf(__uint_as_float(km2[bh * 2]) + __uint_as_float(km2[bh * 2 + 1])) * 1.01f + 1e-3f;
      needc = sqrtf(qs) * kmax + cq; }
    f32x16 o[2];
#pragma unroll
    for (int i = 0; i < 2; ++i)
#pragma unroll
        for (int r = 0; r < 16; ++r) o[i][r] = 0.f;
    float mrun = cq, lrun = 0.f; bool first = true;
    f32x16 negm;
#pragma unroll
    for (int r = 0; r < 16; ++r) negm[r] = 0.f;
    u32x4 kreg[2], vreg[2]; float ckreg = 0.f;
#define FOX_LOAD(thi) do { _Pragma("unroll") for (int ps = 0; ps < 2; ++ps) { const int t_ = (thi) - ps; \
        kreg[ps] = *(const u32x4*)(K + (size_t)(64 * t_ + (tid & 63)) * 4096 + 8 * (tid >> 6)); \
        vreg[ps] = *(const u32x4*)(V + (size_t)(64 * t_ + ((tid & 255) >> 2)) * 4096 + 32 * (tid >> 8) + 8 * (tid & 3)); } \
        if (tid < 128) ckreg = (cum[64 * ((thi) - (tid >> 6)) + (tid & 63)] - cref) * LOG2E; } while (0)
#define FOX_WRITE(buf) do { _Pragma("unroll") for (int ps = 0; ps < 2; ++ps) { \
        *(LAS u32x4*)(lds + OFF_K + ((buf) * 2 + ps) * TB + tid * 16) = kreg[ps]; *(LAS u32x4*)(lds + OFF_V + ((buf) * 2 + ps) * TB + tid * 16) = vreg[ps]; } \
        if (tid < 128) *(LAS float*)(lds + OFF_CK + (buf) * 512 + tid * 4) = ckreg; } while (0)
    const int npairs = u + 1;
    int cur = 0;
    FOX_LOAD(2 * u + 1); FOX_WRITE(0); __syncthreads();
    const int vbase = (4 * hi + ((lane & 15) >> 2)) * 64 + ((lane >> 4) & 1) * 32 + (lane & 3) * 8;
    for (int i = 0; i < npairs; ++i) {
        const int thi = 2 * u + 1 - 2 * i;
        if (i >= 2) {
            const float ckt = *(LAS const float*)(lds + OFF_CK + cur * 512 + 63 * 4);
            LAS const float* nd = (LAS const float*)(lds + OFF_NEED + (cur ^ 1) * 32);
            const f32x4 n0 = *(LAS const f32x4*)nd, n1 = *(LAS const f32x4*)(nd + 4);
            const float nb = fmaxf(fmaxf(fmaxf(n0[0], n0[1]), fmaxf(n0[2], n0[3])), fmaxf(fmaxf(n1[0], n1[1]), fmaxf(n1[2], n1[3])));
            if (ckt >= nb + log2f(64.0f * (float)(thi + 1)) + 24.0f) break;
        }
        if (i + 1 < npairs) FOX_LOAD(thi - 2);
        const int t = thi - kp;
        const bool active = (64 * t <= qpos0w + 31);
        if (active) {
            LAS const unsigned char* Ks = lds + OFF_K + (cur * 2 + kp) * TB; LAS const unsigned char* Vs = lds + OFF_V + (cur * 2 + kp) * TB;
            f32x16 p0 = negm, p1 = negm;
#pragma unroll
            for (int d0 = 0; d0 < 4; ++d0) {
                const bf16x8 k0 = *(LAS const bf16x8*)(Ks + (2 * d0 + hi) * 1024 + r32 * 16);
                const bf16x8 k1 = *(LAS const bf16x8*)(Ks + (2 * d0 + hi) * 1024 + 512 + r32 * 16);
                p0 = __builtin_amdgcn_mfma_f32_32x32x16_bf16(k0, qr[d0], p0, 0, 0, 0);
                p1 = __builtin_amdgcn_mfma_f32_32x32x16_bf16(k1, qr[d0], p1, 0, 0, 0);
            }
            { LAS const float* cks = (LAS const float*)(lds + OFF_CK + cur * 512 + kp * 256);
#pragma unroll
              for (int g4 = 0; g4 < 4; ++g4) {
                  const f32x4 c0 = *(LAS const f32x4*)(cks + 8 * g4 + 4 * hi), c1 = *(LAS const f32x4*)(cks + 32 + 8 * g4 + 4 * hi);
#pragma unroll
                  for (int j = 0; j < 4; ++j) { p0[4 * g4 + j] -= c0[j]; p1[4 * g4 + j] -= c1[j]; }
              } }
            if (64 * t + 63 > qpos0w) {
#pragma unroll
                for (int r = 0; r < 16; ++r) { const int kv = 64 * t + crow(r, hi); if (kv > qpos) p0[r] = -INFINITY; if (kv + 32 > qpos) p1[r] = -INFINITY; }
            }
            float rm = fmaxf(p0[0], p1[0]);
#pragma unroll
            for (int r = 1; r < 16; ++r) rm = fmaxf(rm, fmaxf(p0[r], p1[r]));
            rm = swap_max(rm);
            if (first || __any(rm > 8.0f)) {
                const float dl = first ? rm : fmaxf(rm, 0.f), alpha = first ? 1.0f : __builtin_amdgcn_exp2f(-dl);
                mrun += dl; lrun *= alpha; first = false;
#pragma unroll
                for (int r = 0; r < 16; ++r) { p0[r] -= dl; p1[r] -= dl; negm[r] = cq - mrun; }
                if (hi == 0) wsf[r32] = alpha;
#pragma unroll
                for (int g4 = 0; g4 < 4; ++g4) { const f32x4 a4 = *(LAS const f32x4*)(wsf + 8 * g4 + 4 * hi);
#pragma unroll
                    for (int j = 0; j < 4; ++j) { o[0][4 * g4 + j] *= a4[j]; o[1][4 * g4 + j] *= a4[j]; } }
            }
            float ls = 0.f;
#pragma unroll
            for (int r = 0; r < 16; ++r) { p0[r] = __builtin_amdgcn_exp2f(p0[r]); p1[r] = __builtin_amdgcn_exp2f(p1[r]); ls += p0[r] + p1[r]; }
            lrun += ls;
            bf16x8 pa[4];
            { u32x4 w;
              w.x = cvtpk(p0[0], p0[1]); w.y = cvtpk(p0[2], p0[3]); w.z = cvtpk(p0[4], p0[5]); w.w = cvtpk(p0[6], p0[7]); pa[0] = __builtin_bit_cast(bf16x8, w);
              w.x = cvtpk(p0[8], p0[9]); w.y = cvtpk(p0[10], p0[11]); w.z = cvtpk(p0[12], p0[13]); w.w = cvtpk(p0[14], p0[15]); pa[1] = __builtin_bit_cast(bf16x8, w);
              w.x = cvtpk(p1[0], p1[1]); w.y = cvtpk(p1[2], p1[3]); w.z = cvtpk(p1[4], p1[5]); w.w = cvtpk(p1[6], p1[7]); pa[2] = __builtin_bit_cast(bf16x8, w);
              w.x = cvtpk(p1[8], p1[9]); w.y = cvtpk(p1[10], p1[11]); w.z = cvtpk(p1[12], p1[13]); w.w = cvtpk(p1[14], p1[15]); pa[3] = __builtin_bit_cast(bf16x8, w); }
#pragma unroll
            for (int d0 = 0; d0 < 2; ++d0)
#pragma unroll
                for (int ks = 0; ks < 4; ++ks) {
                    const s16x4 lo = vtr(Vs + d0 * 4096 + ks * 1024 + vbase), hh = vtr(Vs + d0 * 4096 + ks * 1024 + 512 + vbase);
                    const bf16x8 vf = (bf16x8){lo[0], lo[1], lo[2], lo[3], hh[0], hh[1], hh[2], hh[3]};
                    o[d0] = __builtin_amdgcn_mfma_f32_32x32x16_bf16(pa[ks], vf, o[d0], 0, 0, 0);
                }
        }
        {
            float nq = first ? INFINITY : needc - mrun;
#pragma unroll
            for (int ofs = 1; ofs < 32; ofs <<= 1) nq = fmaxf(nq, __shfl_xor(nq, ofs));
            if (lane == 0) *(LAS float*)(lds + OFF_NEED + cur * 32 + wid * 4) = nq;
        }
        if (i + 1 < npairs) FOX_WRITE(cur ^ 1);
        __syncthreads();
        cur ^= 1;
    }
#undef FOX_LOAD
#undef FOX_WRITE
    LAS float* cmb = (LAS float*)(lds + OFF_CMB) + rg * (35 * 64) + lane;
    if (kp == 1) {
#pragma unroll
        for (int r = 0; r < 16; ++r) { cmb[r * 64] = o[0][r]; cmb[(16 + r) * 64] = o[1][r]; }
        cmb[32 * 64] = mrun; cmb[33 * 64] = lrun;
    }
    __syncthreads();
    if (kp == 0) {
        const float m1 = cmb[32 * 64], l1 = cmb[33 * 64];
        const float m = first ? m1 : fmaxf(mrun, m1);
        const float a0 = first ? 0.f : __builtin_amdgcn_exp2f(mrun - m), a1 = __builtin_amdgcn_exp2f(m1 - m);
        const float lt = swap_sum(lrun * a0 + l1 * a1);
        if (hi == 0) { wsf[r32] = a0; wsf[32 + r32] = a1; wsf[64 + r32] = 1.0f / lt; }
        bf16_t* Ob = ATT + (rowb + q0 + 32 * rg) * 512 + 64 * h + r32;
#pragma unroll
        for (int g4 = 0; g4 < 4; ++g4) {
            const f32x4 x0 = *(LAS const f32x4*)(wsf + 8 * g4 + 4 * hi), x1 = *(LAS const f32x4*)(wsf + 32 + 8 * g4 + 4 * hi), xl = *(LAS const f32x4*)(wsf + 64 + 8 * g4 + 4 * hi);
#pragma unroll
            for (int j = 0; j < 4; ++j) { const int r = 4 * g4 + j; bf16_t* orow = Ob + (size_t)crow(r, hi) * 512;
                orow[0] = (bf16_t)f2bf((o[0][r] * x0[j] + cmb[r * 64] * x1[j]) * xl[j]);
                orow[32] = (bf16_t)f2bf((o[1][r] * x0[j] + cmb[(16 + r) * 64] * x1[j]) * xl[j]); }
        }
    }
    __syncthreads();
}

#define SSM_TAKE(idx) do { auto q0_ = __builtin_amdgcn_permlane32_swap(__float_as_uint(xr0), __float_as_uint(xr0), false, false); xr0 = __uint_as_float(q0_[idx]); \
    auto q1_ = __builtin_amdgcn_permlane32_swap(__float_as_uint(xi0), __float_as_uint(xi0), false, false); xi0 = __uint_as_float(q1_[idx]); \
    auto q2_ = __builtin_amdgcn_permlane32_swap(__float_as_uint(xr1), __float_as_uint(xr1), false, false); xr1 = __uint_as_float(q2_[idx]); \
    auto q3_ = __builtin_amdgcn_permlane32_swap(__float_as_uint(xi1), __float_as_uint(xi1), false, false); xi1 = __uint_as_float(q3_[idx]); } while (0)
#define SSM_STEP(r) do { const float a0_ = l0.x * xr0 - l0.y * xi0 + re0[r], b0_ = l0.x * xi0 + l0.y * xr0 + im0[r]; xr0 = a0_; xi0 = b0_; re0[r] = a0_; im0[r] = b0_; \
    const float a1_ = l1.x * xr1 - l1.y * xi1 + re1[r], b1_ = l1.x * xi1 + l1.y * xr1 + im1[r]; xr1 = a1_; xi1 = b1_; re1[r] = a1_; im1[r] = b1_; } while (0)
#define SSM_SCAN32() do { _Pragma("unroll") for (int j_ = 0; j_ < 4; ++j_) { \
        if (hi == 0) { SSM_STEP(4 * j_); SSM_STEP(4 * j_ + 1); SSM_STEP(4 * j_ + 2); SSM_STEP(4 * j_ + 3); } SSM_TAKE(0); \
        if (hi == 1) { SSM_STEP(4 * j_); SSM_STEP(4 * j_ + 1); SSM_STEP(4 * j_ + 2); SSM_STEP(4 * j_ + 3); } SSM_TAKE(1); } } while (0)
#define SSM_BU(ua) do { f32x16 z_; _Pragma("unroll") for (int r_ = 0; r_ < 16; ++r_) z_[r_] = 0.f; \
    re0 = __builtin_amdgcn_mfma_f32_32x32x16_bf16(ua, bt[0], z_, 0, 0, 0); im0 = __builtin_amdgcn_mfma_f32_32x32x16_bf16(ua, bt[1], z_, 0, 0, 0); \
    re1 = __builtin_amdgcn_mfma_f32_32x32x16_bf16(ua, bt[2], z_, 0, 0, 0); im1 = __builtin_amdgcn_mfma_f32_32x32x16_bf16(ua, bt[3], z_, 0, 0, 0); } while (0)

__device__ __forceinline__ void ssm_pass1(const unsigned char* ws, int gw, int ngw, int lane) {
    const bf16_t* proj = (const bf16_t*)(ws + WS_PROJ); const bf16_t* btp = (const bf16_t*)(ws + WS_BT); const float2* lamb = (const float2*)(ws + WS_LAMB);
    float2* E = (float2*)(ws + WS_E);
    const int c = lane & 31, hi = lane >> 5;
    for (int it = gw; it < BATCH * NG * 32; it += ngw) {
        const int c4 = it & 31, g = (it >> 5) & 31, b = it >> 10;
        bf16x8 bt[4];
#pragma unroll
        for (int t = 0; t < 4; ++t) bt[t] = *(const bf16x8*)(btp + (size_t)((g * 4 + t) * 32 + c) * 16 + 8 * hi);
        const float2 l0 = lamb[g * 64 + c], l1 = lamb[g * 64 + 32 + c];
        const bf16_t* up = proj + ((size_t)b * SEQ + 256 * c4 + c) * 4096 + 16 * g + 8 * hi;
        bf16x8 ua = *(const bf16x8*)up;
        float xr0 = 0.f, xi0 = 0.f, xr1 = 0.f, xi1 = 0.f;
#pragma unroll 1
        for (int blk = 0; blk < 8; ++blk) {
            f32x16 re0, im0, re1, im1;
            SSM_BU(ua);
            if (blk < 7) ua = *(const bf16x8*)(up + (size_t)(32 * (blk + 1)) * 4096);
            SSM_SCAN32();
            if (blk & 1) {
                const size_t ei = (size_t)((b * 32 + g) * 128 + 4 * c4 + (blk >> 1)) * 64;
                if (hi == 0) { E[ei + c] = make_float2(xr0, xi0); E[ei + 32 + c] = make_float2(xr1, xi1); }
                xr0 = 0.f; xi0 = 0.f; xr1 = 0.f; xi1 = 0.f;
            }
        }
    }
}
__device__ __forceinline__ float gelu_tanh(float v) {
    const float z = 0.7978845608028654f * (v + 0.044715f * v * v * v);
    const float th = 1.0f - 2.0f * __builtin_amdgcn_rcpf(__expf(2.0f * z) + 1.0f);
    return 0.5f * v * (1.0f + th);
}
__device__ __forceinline__ void cmul(float& ar, float& ai, float br, float bi) { const float r = ar * br - ai * bi, i = ar * bi + ai * br; ar = r; ai = i; }
__device__ __forceinline__ void ssm_pass2(const unsigned char* ws, unsigned char* wsw, const float* dskip, LAS unsigned char* lds, int gw, int ngw, int lane, int wid) {
    const bf16_t* proj = (const bf16_t*)(ws + WS_PROJ); const bf16_t* btp = (const bf16_t*)(ws + WS_BT); const float2* lamb = (const float2*)(ws + WS_LAMB);
    const float2* l64 = (const float2*)(ws + WS_L64); const float2* E = (const float2*)(ws + WS_E); const bf16_t* cm = (const bf16_t*)(ws + WS_CM);
    bf16_t* yssm = (bf16_t*)(wsw + WS_YSSM);
    LAS unsigned char* xs = lds + wid * 8704;
    const int quad = lane >> 4, l15 = lane & 15, c = lane & 31, hi = lane >> 5;
    for (int it = gw; it < BATCH * NG * 32; it += ngw) {
        const int c4 = it & 31, g = (it >> 5) & 31, b = it >> 10;
        bf16x8 bt[4];
#pragma unroll
        for (int t = 0; t < 4; ++t) bt[t] = *(const bf16x8*)(btp + (size_t)((g * 4 + t) * 32 + c) * 16 + 8 * hi);
        const float2 l0 = lamb[g * 64 + c], l1 = lamb[g * 64 + 32 + c], k0 = l64[g * 64 + c], k1 = l64[g * 64 + 32 + c];
        float xr0 = 0.f, xi0 = 0.f, xr1 = 0.f, xi1 = 0.f;
        {
            const int n = 4 * c4, nh = n >> 1;
            const float2* ep = E + (size_t)((b * 32 + g) * 128 + hi * nh) * 64 + c;
#pragma unroll 4
            for (int j0 = 0; j0 < nh; j0 += 2) {
                const float2 e00 = ep[(size_t)j0 * 64], e01 = ep[(size_t)j0 * 64 + 32], e10 = ep[(size_t)(j0 + 1) * 64], e11 = ep[(size_t)(j0 + 1) * 64 + 32];
                cmul(xr0, xi0, k0.x, k0.y); xr0 += e00.x; xi0 += e00.y; cmul(xr1, xi1, k1.x, k1.y); xr1 += e01.x; xi1 += e01.y;
                cmul(xr0, xi0, k0.x, k0.y); xr0 += e10.x; xi0 += e10.y; cmul(xr1, xi1, k1.x, k1.y); xr1 += e11.x; xi1 += e11.y;
            }
            float p0r = 1.f, p0i = 0.f, p1r = 1.f, p1i = 0.f, s0r = k0.x, s0i = k0.y, s1r = k1.x, s1i = k1.y;
            for (int e = nh; e > 0; e >>= 1) { if (e & 1) { cmul(p0r, p0i, s0r, s0i); cmul(p1r, p1i, s1r, s1i); } cmul(s0r, s0i, s0r, s0i); cmul(s1r, s1i, s1r, s1i); }
            float lo0r, lo0i, lo1r, lo1i, h0r, h0i, h1r, h1i;
            { auto q = __builtin_amdgcn_permlane32_swap(__float_as_uint(xr0), __float_as_uint(xr0), false, false); lo0r = __uint_as_float(q[0]); h0r = __uint_as_float(q[1]); }
            { auto q = __builtin_amdgcn_permlane32_swap(__float_as_uint(xi0), __float_as_uint(xi0), false, false); lo0i = __uint_as_float(q[0]); h0i = __uint_as_float(q[1]); }
            { auto q = __builtin_amdgcn_permlane32_swap(__float_as_uint(xr1), __float_as_uint(xr1), false, false); lo1r = __uint_as_float(q[0]); h1r = __uint_as_float(q[1]); }
            { auto q = __builtin_amdgcn_permlane32_swap(__float_as_uint(xi1), __float_as_uint(xi1), false, false); lo1i = __uint_as_float(q[0]); h1i = __uint_as_float(q[1]); }
            cmul(lo0r, lo0i, p0r, p0i); cmul(lo1r, lo1i, p1r, p1i);
            xr0 = lo0r + h0r; xi0 = lo0i + h0i; xr1 = lo1r + h1r; xi1 = lo1i + h1i;
        }
        bf16x8 cb[4];
#pragma unroll
        for (int ks = 0; ks < 4; ++ks) cb[ks] = *(const bf16x8*)(cm + (size_t)(g * 16 + l15) * 128 + 32 * ks + 8 * quad);
        const float dsk = dskip[16 * g + l15];
        const size_t row0 = (size_t)b * SEQ + 256 * c4;
        const bf16_t* up = proj + (row0 + c) * 4096 + 16 * g + 8 * hi;
        bf16x8 ua = *(const bf16x8*)up;
#pragma unroll 1
        for (int blk = 0; blk < 8; ++blk) {
            f32x16 re0, im0, re1, im1;
            SSM_BU(ua);
            if (blk < 7) ua = *(const bf16x8*)(up + (size_t)(32 * (blk + 1)) * 4096);
            float uv[2][4];
#pragma unroll
            for (int mt = 0; mt < 2; ++mt)
#pragma unroll
                for (int j = 0; j < 4; ++j) uv[mt][j] = __uint_as_float((unsigned)proj[(row0 + 32 * blk + 16 * mt + 4 * quad + j) * 4096 + 16 * g + l15] << 16);
            SSM_SCAN32();
#pragma unroll
            for (int r = 0; r < 16; ++r) { const int tok = crow(r, hi);
                *(LAS unsigned*)(xs + tok * 272 + c * 4) = cvtpk(re0[r], im0[r]); *(LAS unsigned*)(xs + tok * 272 + (32 + c) * 4) = cvtpk(re1[r], im1[r]); }
#pragma unroll
            for (int mt = 0; mt < 2; ++mt) {
                f32x4 acc = (f32x4){0.f, 0.f, 0.f, 0.f};
#pragma unroll
                for (int ks = 0; ks < 4; ++ks) { const bf16x8 a = *(LAS const bf16x8*)(xs + (16 * mt + l15) * 272 + (32 * ks + 8 * quad) * 2);
                    acc = __builtin_amdgcn_mfma_f32_16x16x32_bf16(a, cb[ks], acc, 0, 0, 0); }
#pragma unroll
                for (int j = 0; j < 4; ++j) { const size_t row = row0 + 32 * blk + 16 * mt + 4 * quad + j;
                    const float y = gelu_tanh(acc[j] + dsk * uv[mt][j]);
                    yssm[row * 512 + 16 * g + l15] = (bf16_t)f2bf(y); }
            }
        }
    }
}

__device__ __forceinline__ void transpose_item(const float* W, int N, int k0, int csrc, bf16_t* WT, int K, int nrow0, const float* gain, LAS float* scr, int lane) {
#pragma unroll 8
    for (int i = 0; i < 32; ++i) { const int kk = 2 * i + (lane >> 5); float v = W[(size_t)(k0 + kk) * N + csrc + (lane & 31)]; if (gain) v *= gain[k0 + kk]; scr[kk * 33 + (lane & 31)] = v; }
    const int c = lane & 7;
#pragma unroll
    for (int j = 0; j < 4; ++j) { const int n = (lane >> 3) + 8 * j; const LAS float* s = scr + (8 * c) * 33 + n;
        u32x4 o; o.x = pk2(s[0 * 33], s[1 * 33]); o.y = pk2(s[2 * 33], s[3 * 33]); o.z = pk2(s[4 * 33], s[5 * 33]); o.w = pk2(s[6 * 33], s[7 * 33]);
        *(u32x4*)(WT + (size_t)(nrow0 + n) * K + k0 + 8 * c) = o; }
}
__device__ __forceinline__ bool transpose_matrix(int& r, const float* W, int K, int N, int Nd, int mode, int half, bf16_t* WT, const float* gain, LAS float* scr, int lane) {
    const int nblk = Nd / 32, items = (K / 64) * nblk;
    if (r >= items) { r -= items; return false; }
    const int kb = r / nblk, nb = r % nblk, n0 = 32 * nb;
    int csrc = n0;
    if (mode == 1) csrc = n0 >= 2048 ? n0 + 8 : n0;
    if (mode == 2) { const int pn = n0 >> 8, bj = (n0 >> 7) & 1, j = n0 & 127; csrc = bj * half + 128 * pn + j; }
    transpose_item(W, N, 64 * kb, csrc, WT, K, n0, gain, scr, lane);
    return true;
}
__device__ __forceinline__ float log_sigmoid(float z) { return fminf(z, 0.f) - log1pf(expf(-fabsf(z))); }

__device__ __forceinline__ void prologue(const Args& A, LAS unsigned char* lds, int gw, int ngw, int lane, int wid) {
    unsigned char* ws = A.ws;
    const float* x = A.in[0]; const float* mem = A.in[1]; const float* norm_mix = A.in[2]; const float* w_in = A.in[3]; const float* b_forget = A.in[4];
    LAS float* wf = (LAS float*)(lds + 98304);
    for (int i = threadIdx.x; i < 8192; i += NTHR) { const int k = i >> 3, h = i & 7; wf[i] = w_in[(size_t)k * 4104 + 2048 + h] * norm_mix[k]; }
    __syncthreads();
    LAS float* scr = (LAS float*)(lds + wid * 8448);
    {
        constexpr int NITEMS = 16 * 128 + 8 * 64 + 8 * 32 + 16 * 32 + 16 * 16 + 16 * 32 + 8 * 32 + 16 * 176 + 44 * 32;
        for (int it = gw; it < NITEMS * REP_PROW; it += ngw) {
            int r = it % NITEMS;
            if (transpose_matrix(r, A.in[3], 1024, 4104, 4096, 1, 0, (bf16_t*)(ws + WS_WIN), A.in[2], scr, lane)) continue;
            if (transpose_matrix(r, A.in[13], 512, 2048, 2048, 2, 1024, (bf16_t*)(ws + WS_WGLU), nullptr, scr, lane)) continue;
            if (transpose_matrix(r, A.in[14], 512, 1024, 1024, 0, 0, (bf16_t*)(ws + WS_WFO), nullptr, scr, lane)) continue;
            if (transpose_matrix(r, A.in[15], 1024, 1024, 1024, 0, 0, (bf16_t*)(ws + WS_WMO), nullptr, scr, lane)) continue;
            if (transpose_matrix(r, A.in[18], 1024, 512, 512, 0, 0, (bf16_t*)(ws + WS_WMQ), A.in[16], scr, lane)) continue;
            if (transpose_matrix(r, A.in[19], 1024, 1024, 1024, 0, 0, (bf16_t*)(ws + WS_WMKV), A.in[17], scr, lane)) continue;
            if (transpose_matrix(r, A.in[20], 512, 1024, 1024, 0, 0, (bf16_t*)(ws + WS_WMOO), nullptr, scr, lane)) continue;
            if (transpose_matrix(r, A.in[22], 1024, 5632, 5632, 2, 2816, (bf16_t*)(ws + WS_WF1), A.in[21], scr, lane)) continue;
            transpose_matrix(r, A.in[23], 2816, 1024, 1024, 0, 0, (bf16_t*)(ws + WS_WF2), nullptr, scr, lane);
        }
    }
    {
        bf16_t* U = (bf16_t*)(ws + WS_U); float* LF = (float*)(ws + WS_LF);
        for (int mm = gw; mm < M * REP_PROX; mm += ngw) { const int m = mm % M;
            const f32x4* xr = (const f32x4*)(x + (size_t)m * DM) + lane;
            f32x4 v[4]; float s = 0.f;
#pragma unroll
            for (int j = 0; j < 4; ++j) { v[j] = xr[64 * j]; s += (v[j][0] * v[j][0] + v[j][1] * v[j][1]) + (v[j][2] * v[j][2] + v[j][3] * v[j][3]); }
            const float rstd = 1.0f / sqrtf(wave_sum(s) * (1.0f / DM) + RMS_EPS);
            float f[8];
#pragma unroll
            for (int h = 0; h < 8; ++h) f[h] = 0.f;
#pragma unroll
            for (int j = 0; j < 4; ++j)
#pragma unroll
                for (int i = 0; i < 4; ++i) { const int k = 256 * j + 4 * lane + i; const f32x4 wa = *(LAS const f32x4*)(wf + k * 8), wb = *(LAS const f32x4*)(wf + k * 8 + 4); const float xv = v[j][i];
                    f[0] += xv * wa[0]; f[1] += xv * wa[1]; f[2] += xv * wa[2]; f[3] += xv * wa[3]; f[4] += xv * wb[0]; f[5] += xv * wb[1]; f[6] += xv * wb[2]; f[7] += xv * wb[3]; }
            float mine = 0.f;
#pragma unroll
            for (int h = 0; h < 8; ++h) { const float t = wave_sum(f[h]); if (lane == h) mine = t; }
            if (lane < 8) { const int b = m >> 13, t = m & 8191; LF[(size_t)(b * 8 + lane) * SEQ + t] = log_sigmoid(mine * rstd + b_forget[lane]); }
            u32x2* o8 = (u32x2*)(U + (size_t)m * DM) + lane;
#pragma unroll
            for (int j = 0; j < 4; ++j) { u32x2 w; w.x = pk2(v[j][0] * rstd, v[j][1] * rstd); w.y = pk2(v[j][2] * rstd, v[j][3] * rstd); o8[64 * j] = w; }
        }
    }
    {
        bf16_t* MN = (bf16_t*)(ws + WS_MN);
        for (int m = gw; m < BATCH * 256; m += ngw) {
            const f32x4* xr = (const f32x4*)(mem + (size_t)m * DM) + lane;
            f32x4 v[4]; float s = 0.f;
#pragma unroll
            for (int j = 0; j < 4; ++j) { v[j] = xr[64 * j]; s += (v[j][0] * v[j][0] + v[j][1] * v[j][1]) + (v[j][2] * v[j][2] + v[j][3] * v[j][3]); }
            const float rstd = 1.0f / sqrtf(wave_sum(s) * (1.0f / DM) + RMS_EPS);
            u32x2* o8 = (u32x2*)(MN + (size_t)m * DM) + lane;
#pragma unroll
            for (int j = 0; j < 4; ++j) { u32x2 w; w.x = pk2(v[j][0] * rstd, v[j][1] * rstd); w.y = pk2(v[j][2] * rstd, v[j][3] * rstd); o8[64 * j] = w; }
        }
    }
    if (gw < NG) {
        const int g = gw, p = lane, gp = g * 64 + p;
        const float* lam_re = A.in[5]; const float* lam_im = A.in[6]; const float* log_dt = A.in[7];
        const float* b_re = A.in[8]; const float* b_im = A.in[9]; const float* c_re = A.in[10]; const float* c_im = A.in[11];
        const float lr = lam_re[gp], li = lam_im[gp], dt = expf(log_dt[g]);
        const float mag = expf(lr * dt); float sn, cs; sincosf(li * dt, &sn, &cs);
        const float ar = mag * cs, ai = mag * sn;
        ((float2*)(ws + WS_LAMB))[gp] = make_float2(ar, ai);
        float pr = ar, pi = ai;
#pragma unroll
        for (int q = 0; q < 6; ++q) { const float nr = pr * pr - pi * pi, ni = 2.f * pr * pi; pr = nr; pi = ni; }
        ((float2*)(ws + WS_L64))[gp] = make_float2(pr, pi);
        const float den = lr * lr + li * li, nr_ = ar - 1.0f;
        const float cr = (nr_ * lr + ai * li) / den, ci = (ai * lr - nr_ * li) / den;
        bf16_t* btw = (bf16_t*)(ws + WS_BT); const int tre = 2 * (p >> 5), col = p & 31;
#pragma unroll
        for (int n = 0; n < 16; n += 2) { const float br0 = b_re[(size_t)gp * 16 + n], bi0 = b_im[(size_t)gp * 16 + n], br1 = b_re[(size_t)gp * 16 + n + 1], bi1 = b_im[(size_t)gp * 16 + n + 1];
            *(unsigned*)(btw + (size_t)((g * 4 + tre) * 32 + col) * 16 + n) = pk2(cr * br0 - ci * bi0, cr * br1 - ci * bi1);
            *(unsigned*)(btw + (size_t)((g * 4 + tre + 1) * 32 + col) * 16 + n) = pk2(cr * bi0 + ci * br0, cr * bi1 + ci * br1); }
        bf16_t* cmat = (bf16_t*)(ws + WS_CM);
#pragma unroll
        for (int n = 0; n < 16; ++n) { const size_t ci_ = (size_t)(g * 16 + n) * 64 + p;
            *(unsigned*)(cmat + (size_t)(g * 16 + n) * 128 + 2 * p) = pk2(c_re[ci_], -c_im[ci_]); }
    }
}

__device__ __forceinline__ void cumsum_seq(const float* lf, float* cum, int lane) {
    const float* p = lf + 128 * lane; double s = 0.0;
    for (int i = 0; i < 128; ++i) s += (double)p[i];
    double incl = s;
#pragma unroll
    for (int o = 1; o < 64; o <<= 1) { const double t = __shfl_up(incl, o); if (lane >= o) incl += t; }
    double run = incl - s;
    float* q = cum + 128 * lane;
    for (int i = 0; i < 128; ++i) { run += (double)p[i]; q[i] = (float)run; }
}

#define GAS __attribute__((address_space(1)))
#define RLX_AGENT __ATOMIC_RELAXED, __HIP_MEMORY_SCOPE_AGENT
#define XB_TMO      128
#define XB_XCNT(j)  (256  + 64 * (j))
#define XB_XSUB(j)  (1280 + 64 * (j))
#define XB_XGEN(j)  (2304 + 64 * (j))
#define XB_TOP      3328
#define XB_TOPGEN   3392
#define XCD_BAR_WORDS 3456
#define XB_SPIN_CAP (1u << 18)

__device__ __forceinline__ unsigned xb_ld(unsigned* p)              { return __hip_atomic_load(p, __ATOMIC_RELAXED, __HIP_MEMORY_SCOPE_AGENT); }
__device__ __forceinline__ unsigned xb_add(unsigned* p, unsigned v) { return __hip_atomic_fetch_add(p, v, __ATOMIC_RELAXED, __HIP_MEMORY_SCOPE_AGENT); }
__device__ __forceinline__ unsigned xb_xcc_id() { return (unsigned)__builtin_amdgcn_s_getreg((3 << 11) | 20) & 0xFu; }
#define XB_SPIN(cond, bar) do { unsigned _sp = 0; while (cond) { __builtin_amdgcn_s_sleep(1); \
    if ((++_sp & 255u) == 0u) { if (xb_ld(&(bar)[XB_TMO])) break; if (_sp > XB_SPIN_CAP) { atomicAdd(&(bar)[XB_TMO], 1u); break; } } } } while (0)

struct XcdBarrier {
    unsigned* bar; unsigned x;
    volatile LAS unsigned* st;
};

__device__ __forceinline__ XcdBarrier xcd_barrier_post(unsigned* bar, volatile LAS unsigned* st) {
    XcdBarrier b; b.bar = bar; b.x = xb_xcc_id(); b.st = st;
    if (threadIdx.x == 0) (void)xb_add(&bar[XB_XCNT(b.x)], 1u);
    return b;
}
__device__ __forceinline__ void xcd_barrier_complete(unsigned* bar, unsigned x, unsigned& nloc, unsigned& nx) {
    const unsigned G = gridDim.x * gridDim.y * gridDim.z;
    unsigned sum, cnt, mine, sp = 0u;
    for (;;) {
        sum = 0u; cnt = 0u; mine = 0u;
#pragma unroll
        for (unsigned j = 0; j < 16; ++j) { const unsigned c = xb_ld(&bar[XB_XCNT(j)]); sum += c; cnt += (c > 0u) ? 1u : 0u; mine = (j == x) ? c : mine; }
        if (sum == G) break;
        __builtin_amdgcn_s_sleep(1);
        if ((++sp & 255u) == 0u) { if (xb_ld(&bar[XB_TMO])) break; if (sp > XB_SPIN_CAP) { atomicAdd(&bar[XB_TMO], 1u); break; } }
    }
    nloc = mine > 0u ? mine : 1u; nx = cnt > 0u ? cnt : 1u;
}

__device__ __forceinline__ void xcd_barrier(const XcdBarrier& b) {
    asm volatile("s_waitcnt vmcnt(0)" ::: "memory");
    __syncthreads();
    if (threadIdx.x == 0) {
        unsigned* bar = b.bar;
        __builtin_amdgcn_s_waitcnt(0);
        unsigned nloc = b.st[0], nx = b.st[1];
        if (nloc == 0u) { xcd_barrier_complete(bar, b.x, nloc, nx); b.st[0] = nloc; b.st[1] = nx; }
        const unsigned old = xb_add(&bar[XB_XSUB(b.x)], 1u);
        const unsigned gen = old / nloc;
        if (old + 1u == (gen + 1u) * nloc) {
            __builtin_amdgcn_fence(__ATOMIC_RELEASE, "agent");
            asm volatile("s_waitcnt vmcnt(0)" ::: "memory");
            const unsigned og = xb_add(&bar[XB_TOP], 1u);
            const unsigned tg = og / nx;
            if (og + 1u == (tg + 1u) * nx) xb_add(&bar[XB_TOPGEN], 1u);
            else XB_SPIN(xb_ld(&bar[XB_TOPGEN]) == tg, bar);
            __builtin_amdgcn_fence(__ATOMIC_ACQUIRE, "agent");
            xb_add(&bar[XB_XGEN(b.x)], 1u);
            asm volatile("s_waitcnt vmcnt(0)" ::: "memory");
        } else {
            XB_SPIN(xb_ld(&bar[XB_XGEN(b.x)]) == gen, bar);
            __builtin_amdgcn_fence(__ATOMIC_ACQUIRE, "agent");
            asm volatile("s_waitcnt vmcnt(0)" ::: "memory");
        }
    }
    __syncthreads();
}

__global__ void __launch_bounds__(NTHR, 2) fwd_kernel(Args args) {
    extern __shared__ __attribute__((aligned(16))) unsigned char lds_raw[];
    LAS unsigned char* lds = (LAS unsigned char*)lds_raw;
    cg::grid_group grid = cg::this_grid();
    const int tid = threadIdx.x, lane = tid & 63, wid = __builtin_amdgcn_readfirstlane(tid >> 6);
    const int G = gridDim.x, bx = blockIdx.x;
    const int vcu = (G % 8 == 0) ? (bx % 8) * (G / 8) + bx / 8 : bx;
    const int gw = vcu * NWAVES + wid, ngw = G * NWAVES;
    unsigned char* ws = args.ws;
    const int lo = args.ph_lo, hi = args.ph_hi;
#define IN(k) (lo <= (k) && (k) < hi)
    volatile LAS unsigned* bst = (volatile LAS unsigned*)(lds + 131072 + 512);
    if (tid < 2) bst[tid] = 0u;
    __syncthreads();
    const bool multi = (hi - lo) > 1;
    XcdBarrier xbar; xbar.bar = (unsigned*)(ws + WS_BAR); xbar.x = 0; xbar.st = bst;
    if (multi) xbar = xcd_barrier_post((unsigned*)(ws + WS_BAR), bst);
    if (lo < 0) grid.sync();
#define SEAM(k) do { if (IN(k) && IN((k) + 1)) { for (int rep_ = 0; rep_ < REP_SYNC; ++rep_) xcd_barrier(xbar); } } while (0)
    bf16_t* PROJ = (bf16_t*)(ws + WS_PROJ); bf16_t* MIX = (bf16_t*)(ws + WS_U); bf16_t* HB = (bf16_t*)(ws + WS_HB);

    if (IN(0)) { prologue(args, lds, gw, ngw, lane, wid); }
    SEAM(0);
    if (IN(1)) {
        if (bx < 16 && wid == 0) cumsum_seq((const float*)(ws + WS_LF) + (size_t)bx * SEQ, (float*)(ws + WS_CUM) + (size_t)bx * SEQ, lane);
        pg8::Gemm g{(const bf16_t*)(ws + WS_U), (const bf16_t*)(ws + WS_WIN), M, 4096, 1024}; pg8::StaticOrder S; S.init(M, 4096, G, bx);
        pg8::EpiProj E{PROJ, 0.125f * LOG2E, (unsigned*)(ws + WS_KM2)};
        for (int rep = 0; rep < REP_G1; ++rep) pg8::gemm_phase<pg8::EpiProj, pg8::StaticOrder, true, true>(lds, g, S, E);
    }
    SEAM(1);
    if (IN(2)) {
        for (int rep = 0; rep < REP_SSM1; ++rep) ssm_pass1(ws, gw, ngw, lane);
        {
            LAS int* qslot = (LAS int*)(lds + 131072 + 768);
            unsigned* qcnt = (unsigned*)(ws + WS_QCNT);
            for (int rep = 0; rep < REP_ATT; ++rep)
            for (;;) {
                if (tid == 0) *qslot = (int)atomicAdd(qcnt, 1u);
                __syncthreads();
                const int j = *qslot - rep * (1024 + G);
                __syncthreads();
                if (j >= 1024) break;
                fox_unit(lds, PROJ, (bf16_t*)(ws + WS_ATT), (const float*)(ws + WS_CUM), (const unsigned*)(ws + WS_KM2), j & 15, 63 - (j >> 4));
            }
        }
    }
    SEAM(2);
    if (IN(3)) { for (int rep = 0; rep < REP_SSM2; ++rep) ssm_pass2(ws, ws, args.in[12], lds, gw, ngw, lane, wid); }
    SEAM(3);
    if (IN(4)) {
        pg8::Gemm g{(const bf16_t*)(ws + WS_YSSM), (const bf16_t*)(ws + WS_WGLU), M, 2048, 512}; pg8::StaticOrder S; S.init(M, 2048, G, bx);
        pg8::EpiGlu E{PROJ, MIX};
        pg8::gemm_phase<pg8::EpiGlu, pg8::StaticOrder, true, true>(lds, g, S, E);
    }
    SEAM(4);
    if (IN(5)) {
        pg8::Gemm g{(const bf16_t*)(ws + WS_ATT), (const bf16_t*)(ws + WS_WFO), M, 1024, 512}; pg8::StaticOrder S; S.init(M, 1024, G, bx);
        pg8::EpiFoxO E{PROJ, MIX};
        pg8::gemm_phase<pg8::EpiFoxO, pg8::StaticOrder, true, true>(lds, g, S, E);
    }
    SEAM(5);
    if (IN(6)) {
        pg8::Gemm g{MIX, (const bf16_t*)(ws + WS_WMO), M, 1024, 1024}; pg8::StaticOrder S; S.init(M, 1024, G, bx);
        pg8::EpiRes E{args.in[0], args.out, HB, (float*)(ws + WS_SSQ1)};
        pg8::gemm_phase<pg8::EpiRes, pg8::StaticOrder, true, true>(lds, g, S, E);
    }
    SEAM(6);
    if (IN(7)) {
        if (bx < 128) {
            pg8::Gemm g{HB, (const bf16_t*)(ws + WS_WMQ), M, 512, 1024}; pg8::StaticOrder S; S.init(M, 512, G, bx);
            pg8::EpiPlain E{(bf16_t*)(ws + WS_QM), 512, (const float*)(ws + WS_SSQ1), 0.08838834764831845f * LOG2E};
            pg8::gemm_phase<pg8::EpiPlain, pg8::StaticOrder, true, true>(lds, g, S, E);
        } else {
            pg8::Gemm g{(const bf16_t*)(ws + WS_MN), (const bf16_t*)(ws + WS_WMKV), 512, 1024, 1024}; pg8::StaticOrder S; S.init(512, 1024, G, bx - 128);
            pg8::EpiPlain E{(bf16_t*)(ws + WS_KVM), 1024, nullptr, 1.0f};
            pg8::gemm_phase<pg8::EpiPlain, pg8::StaticOrder, true, true>(lds, g, S, E);
        }
    }
    SEAM(7);
    if (IN(8)) {
        for (int rep = 0; rep < REP_MATT; ++rep) for (int un = vcu; un < 256; un += G) { const int qb = un & 31, hm = (un >> 5) & 3, b = un >> 7;
            const size_t qrow = (size_t)b * SEQ + 256 * qb; const bf16_t* kv = (const bf16_t*)(ws + WS_KVM) + (size_t)b * 256 * 1024;
            attn_unit<128, false>(lds, (const bf16_t*)(ws + WS_QM) + qrow * 512 + 128 * hm, kv + 128 * hm, kv + 512 + 128 * hm,
                                  (bf16_t*)(ws + WS_OM) + qrow * 512 + 128 * hm, 512, 1024, 512, 4, nullptr, 0); }
    }
    SEAM(8);
    if (IN(9)) {
        pg8::Gemm g{(const bf16_t*)(ws + WS_OM), (const bf16_t*)(ws + WS_WMOO), M, 1024, 512}; pg8::StaticOrder S; S.init(M, 1024, G, bx);
        pg8::EpiRes E{args.out, args.out, HB, (float*)(ws + WS_SSQ2)};
        pg8::gemm_phase<pg8::EpiRes, pg8::StaticOrder, true, true>(lds, g, S, E);
    }
    SEAM(9);
    if (IN(10)) {
        pg8::Gemm g{HB, (const bf16_t*)(ws + WS_WF1), M, 2 * FFH, 1024}; pg8::StaticOrder S; S.init(M, 2 * FFH, G, bx);
        pg8::EpiFfn E{(const float*)(ws + WS_SSQ2), (bf16_t*)(ws + WS_HID)};
        for (int rep = 0; rep < REP_G7; ++rep) pg8::gemm_phase<pg8::EpiFfn, pg8::StaticOrder, true, true>(lds, g, S, E);
    }
    SEAM(10);
    if (IN(11)) {
        pg8::Gemm g{(const bf16_t*)(ws + WS_HID), (const bf16_t*)(ws + WS_WF2), M, 1024, FFH}; pg8::StaticOrder S; S.init(M, 1024, G, bx);
        pg8::EpiRes E{args.out, args.out, nullptr, (float*)(ws + WS_SSQ3)};
        pg8::gemm_phase<pg8::EpiRes, pg8::StaticOrder, true, true>(lds, g, S, E);
    }
    SEAM(11);
    if (IN(12)) {
        const float* gn = args.in[24]; const float* ssq = (const float*)(ws + WS_SSQ3);
        for (int m = gw; m < M; m += ngw) {
            const float rs = pg8::row_rstd(ssq, m);
            f32x4* xr = (f32x4*)(args.out + (size_t)m * DM) + lane; const f32x4* gr = (const f32x4*)gn + lane;
#pragma unroll
            for (int j = 0; j < 4; ++j) { const f32x4 v = xr[64 * j] * rs * gr[64 * j]; xr[64 * j] = v; }
        }
    }
#undef IN
#undef SEAM
}

constexpr int NPHASE = 13;
extern "C" void kernel_launch(void* const* d_in, const int* in_sizes, int n_in, void* d_out, int out_size, void* d_ws, size_t ws_size, hipStream_t stream) {
    static int grid = 0;
    if (grid == 0) {
        if (n_in != 25 || out_size != M * DM || ws_size < WS_END) { fprintf(stderr, "kernel_launch: unexpected shapes (n_in %d out %d ws %zu)\n", n_in, out_size, ws_size); grid = -1; return; }
        int dev = 0, cus = 0, per_cu = 0;
        (void)hipGetDevice(&dev); (void)hipDeviceGetAttribute(&cus, hipDeviceAttributeMultiprocessorCount, dev);
        if (hipFuncSetAttribute((const void*)fwd_kernel, hipFuncAttributeMaxDynamicSharedMemorySize, LDS_BYTES) != hipSuccess) { fprintf(stderr, "kernel_launch: hipFuncSetAttribute failed\n"); grid = -1; return; }
        if (hipOccupancyMaxActiveBlocksPerMultiprocessor(&per_cu, (const void*)fwd_kernel, NTHR, LDS_BYTES) != hipSuccess || per_cu < 1) fprintf(stderr, "kernel_launch: occupancy query says %d\n", per_cu);
        (void)hipGetLastError();
        grid = cus > 0 ? cus : 256;
    }
    if (grid < 0) return;
    Args a{};
    for (int i = 0; i < 25; ++i) a.in[i] = (const float*)d_in[i];
    a.out = (float*)d_out; a.ws = (unsigned char*)d_ws;
    (void)hipMemsetAsync((unsigned char*)d_ws + WS_BAR, 0, BAR_BYTES, stream);
#if MK_ONE_LAUNCH
    a.ph_lo = 0; a.ph_hi = NPHASE;
    void* kargs[] = {&a};
    hipError_t e = hipLaunchCooperativeKernel((const void*)fwd_kernel, dim3(grid), dim3(NTHR), kargs, LDS_BYTES, stream);
    if (e != hipSuccess) fprintf(stderr, "cooperative launch failed: %s (grid %d)\n", hipGetErrorString(e), grid);
#else
    for (int ph = 0; ph < NPHASE; ++ph) { a.ph_lo = ph; a.ph_hi = ph + 1; hipLaunchKernelGGL(fwd_kernel, dim3(grid), dim3(NTHR), LDS_BYTES, stream, a); }
#endif
}
```
